# Optimizing an MI355X kernel written in HIP

```python
import math
import jax, jax.numpy as jnp
from jax import lax
import numpy as np

D_MODEL = 1024
BATCH = 16
SEQ = 4096
DEPTH = 2
DEC_BATCH = 16
DEC_SEQ = 2048
PAST_LEN = 128

D_MIX = D_MODEL
N_GROUPS = 4
W_GROUP = D_MIX // N_GROUPS
H_A = 4
NOPE_A = 64
ROPE_A = 32
V_A = W_GROUP // H_A
Q_LORA = 192
KV_LORA = 128
H_B = 4
DK_B = 32
DV_B = W_GROUP // H_B
W_C = W_GROUP
H_C = 4
BW_C = W_C // H_C
CONV_W = 4
CONV_PAD_L = CONV_W // 2
LRU_C = 8.0
H_D = 4
KV_H_D = 2
HD_D = W_GROUP // H_D
GRID_W = 64
ROPE_THETA = 500000.0
ROPE_FRAC = 4
MLA_ROPE_THETA = 10000.0
AXIAL_THETA = 10000.0
Q_BLOCK = 128
EPS = 1e-6
IN_SIZES = (Q_LORA, KV_LORA, ROPE_A, W_GROUP,
            H_B * 2 * DK_B, H_B * 2 * DK_B, H_B * DV_B, W_GROUP,
            W_C, W_GROUP,
            H_D * HD_D, KV_H_D * HD_D, KV_H_D * HD_D, W_GROUP)
N_IN = sum(IN_SIZES)

kernel_name = 'hybrid_hymba_encoder_two_groups'


def rms_norm(x, g):
    xf = x.astype(jnp.float32)
    y = xf * lax.rsqrt(jnp.mean(xf * xf, axis=-1, keepdims=True) + EPS)
    return (y * g.astype(jnp.float32)).astype(x.dtype)


def rope(x, pos, theta):
    half = x.shape[-1] // 2
    inv = jnp.power(jnp.float32(theta), -jnp.arange(half, dtype=jnp.float32) / half)
    ang = pos[:, None] * inv[None, :]
    cos = jnp.cos(ang)[None, :, None, :]
    sin = jnp.sin(ang)[None, :, None, :]
    xf = x.astype(jnp.float32)
    x1, x2 = xf[..., :half], xf[..., half:]
    return jnp.concatenate([x1 * cos - x2 * sin, x2 * cos + x1 * sin], axis=-1).astype(x.dtype)


def partial_rope(x, pos):
    r = x.shape[-1] // ROPE_FRAC
    return jnp.concatenate([rope(x[..., :r], pos, ROPE_THETA), x[..., r:]], axis=-1)


def axial_rope(x, row, col):
    half = x.shape[-1] // 2
    return jnp.concatenate([rope(x[..., :half], row, AXIAL_THETA),
                            rope(x[..., half:], col, AXIAL_THETA)], axis=-1)


def blocked_attention(q, k, v, scale):
    b, s, h, dk = q.shape
    g = k.shape[2]
    rep = h // g
    dv = v.shape[-1]
    nb = s // Q_BLOCK
    qb = q.reshape(b, nb, Q_BLOCK, g, rep, dk).transpose(1, 0, 2, 3, 4, 5)

    def one_block(qblk):
        sc = jnp.einsum('bqgrd,bkgd->bgrqk', qblk, k, preferred_element_type=jnp.float32) * scale
        p = jax.nn.softmax(sc, axis=-1).astype(v.dtype)
        return jnp.einsum('bgrqk,bkgv->bqgrv', p, v)

    out = lax.map(one_block, qb)
    return out.transpose(1, 0, 2, 3, 4, 5).reshape(b, s, h, dv)


def mla_branch(q_lat, kv_lat, k_rope, pos, q_norm, w_uq, kv_norm, w_ukv):
    b, s, _ = q_lat.shape
    q = (rms_norm(q_lat, q_norm) @ w_uq).reshape(b, s, H_A, NOPE_A + ROPE_A)
    kv = (rms_norm(kv_lat, kv_norm) @ w_ukv).reshape(b, s, H_A, NOPE_A + V_A)
    q_nope, q_pe = q[..., :NOPE_A], q[..., NOPE_A:]
    k_nope, v = kv[..., :NOPE_A], kv[..., NOPE_A:]
    q_pe = rope(q_pe, pos, MLA_ROPE_THETA)
    k_pe = rope(k_rope[:, :, None, :], pos, MLA_ROPE_THETA)
    qf = jnp.concatenate([q_nope, q_pe], axis=-1)
    kf = jnp.concatenate([k_nope, jnp.broadcast_to(k_pe, (b, s, H_A, ROPE_A))], axis=-1)
    o = blocked_attention(qf, kf, v, (NOPE_A + ROPE_A) ** -0.5)
    return o.reshape(b, s, H_A * V_A)


def diff_branch(q, k, v, pos, lam, subln, layer_idx):
    b, s, _ = q.shape
    q = partial_rope(q.reshape(b, s, 2 * H_B, DK_B), pos).reshape(b, s, H_B, 2, DK_B)
    k = partial_rope(k.reshape(b, s, 2 * H_B, DK_B), pos).reshape(b, s, H_B, 2, DK_B)
    v = v.reshape(b, s, H_B, DV_B)
    lam_init = 0.8 - 0.6 * math.exp(-0.3 * layer_idx)
    lf = lam.astype(jnp.float32)
    lam_full = jnp.exp(jnp.sum(lf[0] * lf[1])) - jnp.exp(jnp.sum(lf[2] * lf[3])) + lam_init
    o1 = blocked_attention(q[..., 0, :], k[..., 0, :], v, DK_B ** -0.5)
    o2 = blocked_attention(q[..., 1, :], k[..., 1, :], v, DK_B ** -0.5)
    o = o1 - lam_full.astype(o1.dtype) * o2
    o = rms_norm(o, subln) * (1.0 - lam_init)
    return o.reshape(b, s, H_B * DV_B)


def blockdiag(x, w):
    b, s, _ = x.shape
    return jnp.einsum('bshi,hij->bshj', x.reshape(b, s, H_C, BW_C), w).reshape(b, s, W_C)


def scan_combine(e1, e2):
    a1, b1 = e1
    a2, b2 = e2
    return a1 * a2, a2 * b1 + b2


def rglru_branch(xc, conv_w, conv_b, wa, ba, wx, bx, lam):
    b, s, _ = xc.shape
    xp = jnp.pad(xc, ((0, 0), (CONV_PAD_L, CONV_W - 1 - CONV_PAD_L), (0, 0)))
    xconv = conv_b + xp[:, 0:s] * conv_w[0]
    for j in range(1, CONV_W):
        xconv = xconv + xp[:, j:j + s] * conv_w[j]

    def direction(d, reverse):
        r = jax.nn.sigmoid(blockdiag(xconv, wa[d]) + ba[d]).astype(jnp.float32)
        i = jax.nn.sigmoid(blockdiag(xconv, wx[d]) + bx[d])
        log_a = -LRU_C * r * jax.nn.softplus(-lam[d].astype(jnp.float32))
        a = jnp.exp(log_a)
        gx = jnp.sqrt(-jnp.expm1(2.0 * log_a)) * (i * xconv).astype(jnp.float32)
        _, h = lax.associative_scan(scan_combine, (a, gx), axis=1, reverse=reverse)
        return h

    h = direction(0, False) + direction(1, True)
    return h.astype(xc.dtype)


def gqa_branch(q, k, v, row, col, q_norm, k_norm):
    b, s, _ = q.shape
    q = axial_rope(rms_norm(q.reshape(b, s, H_D, HD_D), q_norm), row, col)
    k = axial_rope(rms_norm(k.reshape(b, s, KV_H_D, HD_D), k_norm), row, col)
    v = v.reshape(b, s, KV_H_D, HD_D)
    o = blocked_attention(q, k, v, HD_D ** -0.5)
    return o.reshape(b, s, H_D * HD_D)


def layer(x, c, l, p, pos, row, col):
    mod = jax.nn.silu(c) @ p['ada_w'][l] + p['ada_b'][l]
    shift, scale, gate = jnp.split(mod, 3, axis=-1)
    h = rms_norm(x, p['norm_g'][l]) * (1.0 + scale[:, None, :]) + shift[:, None, :]
    z = h @ p['w_in'][l]
    points = np.cumsum(IN_SIZES)[:-1].tolist()
    (qa, kva, kra, ga, qb, kb, vb, gb, xc, gc, qd, kd, vd, gd) = jnp.split(z, points, axis=-1)
    oa = mla_branch(qa, kva, kra, pos, p['mla_q_norm'][l], p['mla_w_uq'][l],
                    p['mla_kv_norm'][l], p['mla_w_ukv'][l])
    ob = diff_branch(qb, kb, vb, pos, p['diff_lambda'][l], p['diff_subln'][l], l)
    oc = rglru_branch(xc, p['lru_conv_w'][l], p['lru_conv_b'][l], p['lru_wa'][l], p['lru_ba'][l],
                      p['lru_wx'][l], p['lru_bx'][l], p['lru_lambda'][l])
    od = gqa_branch(qd, kd, vd, row, col, p['gqa_q_norm'][l], p['gqa_k_norm'][l])
    o = jnp.concatenate([oa * jax.nn.silu(ga), ob * jax.nn.silu(gb),
                         oc * jax.nn.silu(gc), od * jax.nn.silu(gd)], axis=-1)
    return x + gate[:, None, :] * (o @ p['w_out'][l])


def trunk(x, c, p):
    s = x.shape[1]
    rows = s // GRID_W
    pos = jnp.arange(s, dtype=jnp.float32)
    row = jnp.repeat(jnp.arange(rows, dtype=jnp.float32), GRID_W)
    col = jnp.tile(jnp.arange(GRID_W, dtype=jnp.float32), rows)
    for l in range(DEPTH):
        x = layer(x, c, l, p, pos, row, col)
    return rms_norm(x, p['final_norm'])


def setup_inputs(seed: int = 0) -> dict:
    key = jax.random.key(seed)
    ks = jax.random.split(key, 25)
    f32 = jnp.float32

    def nrm(k, shape, scale):
        return jax.random.normal(k, shape, f32) * scale

    def gain(k, shape):
        return 1.0 + 0.02 * jax.random.normal(k, shape, f32)

    u = jax.random.uniform(ks[20], (DEPTH, 2, W_C), f32, 0.9, 0.999)
    a_base = u ** (1.0 / LRU_C)
    lru_lambda = jnp.log(a_base) - jnp.log1p(-a_base)
    return {
        'x_prompt': nrm(ks[0], (BATCH, SEQ, D_MODEL), 1.0),
        'x_sample': nrm(ks[1], (DEC_BATCH, DEC_SEQ, D_MODEL), 1.0),
        'c_prompt': nrm(ks[2], (BATCH, D_MODEL), 1.0),
        'c_sample': nrm(ks[3], (DEC_BATCH, D_MODEL), 1.0),
        'ada_w': nrm(ks[4], (DEPTH, D_MODEL, 3 * D_MODEL), 0.5 * D_MODEL ** -0.5),
        'ada_b': nrm(ks[5], (DEPTH, 3 * D_MODEL), 0.02),
        'norm_g': gain(ks[6], (DEPTH, D_MODEL)),
        'w_in': nrm(ks[7], (DEPTH, D_MODEL, N_IN), D_MODEL ** -0.5),
        'mla_q_norm': gain(ks[8], (DEPTH, Q_LORA)),
        'mla_w_uq': nrm(ks[9], (DEPTH, Q_LORA, H_A * (NOPE_A + ROPE_A)), Q_LORA ** -0.5),
        'mla_kv_norm': gain(ks[10], (DEPTH, KV_LORA)),
        'mla_w_ukv': nrm(ks[11], (DEPTH, KV_LORA, H_A * (NOPE_A + V_A)), KV_LORA ** -0.5),
        'diff_lambda': nrm(ks[12], (DEPTH, 4, DK_B), 0.1),
        'diff_subln': gain(ks[13], (DEPTH, DV_B)),
        'lru_conv_w': nrm(ks[14], (DEPTH, CONV_W, W_C), CONV_W ** -0.5),
        'lru_conv_b': nrm(ks[15], (DEPTH, W_C), 0.02),
        'lru_wa': nrm(ks[16], (DEPTH, 2, H_C, BW_C, BW_C), BW_C ** -0.5),
        'lru_ba': nrm(ks[17], (DEPTH, 2, W_C), 0.02),
        'lru_wx': nrm(ks[18], (DEPTH, 2, H_C, BW_C, BW_C), BW_C ** -0.5),
        'lru_bx': nrm(ks[19], (DEPTH, 2, W_C), 0.02),
        'lru_lambda': lru_lambda,
        'gqa_q_norm': gain(ks[21], (DEPTH, HD_D)),
        'gqa_k_norm': gain(ks[22], (DEPTH, HD_D)),
        'w_out': nrm(ks[23], (DEPTH, D_MIX, D_MODEL), D_MIX ** -0.5),
        'final_norm': gain(ks[24], (D_MODEL,)),
    }


def reference(x_prompt, x_sample, c_prompt, c_sample, ada_w, ada_b, norm_g, w_in,
              mla_q_norm, mla_w_uq, mla_kv_norm, mla_w_ukv, diff_lambda, diff_subln,
              lru_conv_w, lru_conv_b, lru_wa, lru_ba, lru_wx, lru_bx, lru_lambda,
              gqa_q_norm, gqa_k_norm, w_out, final_norm):
    p = dict(ada_w=ada_w, ada_b=ada_b, norm_g=norm_g, w_in=w_in,
             mla_q_norm=mla_q_norm, mla_w_uq=mla_w_uq, mla_kv_norm=mla_kv_norm, mla_w_ukv=mla_w_ukv,
             diff_lambda=diff_lambda, diff_subln=diff_subln,
             lru_conv_w=lru_conv_w, lru_conv_b=lru_conv_b, lru_wa=lru_wa, lru_ba=lru_ba,
             lru_wx=lru_wx, lru_bx=lru_bx, lru_lambda=lru_lambda,
             gqa_q_norm=gqa_q_norm, gqa_k_norm=gqa_k_norm, w_out=w_out, final_norm=final_norm)
    y_prompt = trunk(x_prompt, c_prompt, p)
    y_sample = trunk(x_sample, c_sample, p)
    return (y_prompt, y_sample)
```

```cpp
#include <hip/hip_runtime.h>
#include <hip/hip_cooperative_groups.h>
#include <cstdio>
#include <cstdint>
namespace cg = cooperative_groups;

typedef unsigned short bf16_t;
using bf16x8 = __attribute__((ext_vector_type(8))) short;
using f32x16 = __attribute__((ext_vector_type(16))) float;
typedef __bf16 bf16x2_t __attribute__((ext_vector_type(2)));
typedef float f32x2_t __attribute__((ext_vector_type(2)));
using u32x4 = __attribute__((ext_vector_type(4))) unsigned;
using u32x2 = __attribute__((ext_vector_type(2))) unsigned;
#define DI __device__ __forceinline__
#define MFMA(a, b, c) __builtin_amdgcn_mfma_f32_32x32x16_bf16((a), (b), (c), 0, 0, 0)

constexpr int T_TOK = 98304, T_P = 65536, DM = 1024, ZS = 2944, NIN = 2912;
constexpr int ZC_QB = 0, ZC_KB = 256, ZC_VB = 512, ZC_GB = 768, ZC_XC = 1024, ZC_GC = 1280, ZC_QD = 1536,
              ZC_KD = 1792, ZC_VD = 1920, ZC_GD = 2048, ZC_GA = 2304, ZC_QA = 2560, ZC_KVA = 2752, ZC_KRA = 2880;
constexpr float LOG2E = 1.4426950408889634f;
constexpr float EPSN = 1e-6f;

constexpr size_t OFF_H = 0;
constexpr size_t SZ_H = (size_t)T_TOK * 1024 * 2;
constexpr size_t OFF_QA = OFF_H;
constexpr size_t OFF_KA = OFF_H + (size_t)T_TOK * 384 * 2;
constexpr size_t OFF_VTA = OFF_H + (size_t)T_TOK * 768 * 2;
constexpr size_t OFF_Z = OFF_H + SZ_H;
constexpr size_t OFF_VTB = OFF_Z + (size_t)T_TOK * ZS * 2;
constexpr size_t OFF_VTD = OFF_VTB + (size_t)T_TOK * 256 * 2;
constexpr size_t OFF_HFB = OFF_VTD + (size_t)T_TOK * 128 * 2;
constexpr size_t OFF_WIN = OFF_HFB + (size_t)T_TOK * 512 * 2;
constexpr size_t OFF_WOUT = OFF_WIN + (size_t)2 * 3072 * 1024 * 2;
constexpr size_t OFF_WUQ = OFF_WOUT + (size_t)2 * 1024 * 1280 * 2;
constexpr size_t OFF_WUKV = OFF_WUQ + (size_t)2 * 512 * 192 * 2;
constexpr size_t OFF_WLRU = OFF_WUKV + (size_t)2 * 512 * 128 * 2;
constexpr size_t OFF_MOD = OFF_WLRU + (size_t)2 * 2 * 2 * 4 * 64 * 64 * 2;
constexpr size_t OFF_TABM = OFF_MOD + (size_t)2 * 32 * 3072 * 4;
constexpr size_t OFF_TABP = OFF_TABM + (size_t)4096 * 16 * 8;
constexpr size_t OFF_TABX = OFF_TABP + (size_t)4096 * 4 * 8;
constexpr size_t OFF_LAM = OFF_TABX + (size_t)64 * 16 * 8;
constexpr size_t OFF_CTR = OFF_LAM + 256;
constexpr size_t OFF_RSS = OFF_CTR + 256;
constexpr size_t WS_NEED = OFF_RSS + (size_t)T_TOK * 8 * 4;

struct Params {
  const float* xin0; const float* xin1; const float* c0; const float* c1;
  const float *ada_w, *ada_b, *norm_g, *w_in, *mla_q_norm, *mla_w_uq, *mla_kv_norm, *mla_w_ukv,
      *diff_lambda, *diff_subln, *conv_w, *conv_b, *lru_wa, *lru_ba, *lru_wx, *lru_bx, *lru_lambda,
      *gqa_q_norm, *gqa_k_norm, *w_out, *final_norm;
  float* out;
  char* ws;
};

DI unsigned pack2(float a, float b) { f32x2_t v = {a, b}; bf16x2_t o = __builtin_convertvector(v, bf16x2_t); return __builtin_bit_cast(unsigned, o); }
DI bf16_t f2bf(float a) { return (bf16_t)(pack2(a, 0.f) & 0xffffu); }
DI float bf2f(bf16_t v) { return __uint_as_float(((unsigned)v) << 16); }
DI float bflo(unsigned u) { return __uint_as_float(u << 16); }
DI float bfhi(unsigned u) { return __uint_as_float(u & 0xffff0000u); }
DI int opaque_tid() { int t = threadIdx.x; asm volatile("" : "+v"(t)); return t; }
DI int crow(int i, int h) { return (i & 3) + 8 * (i >> 2) + 4 * h; }
DI int seq_start(int seq) { return seq < 16 ? (seq << 12) : T_P + ((seq - 16) << 11); }
DI int seq_len(int seq) { return seq < 16 ? 4096 : 2048; }
DI void tok2seq(int t, int& seq, int& s) { if (t < T_P) { seq = t >> 12; s = t & 4095; } else { int u = t - T_P; seq = 16 + (u >> 11); s = u & 2047; } }
DI float silu_f(float x) { return x / (1.f + __expf(-x)); }
DI float sigmoid_f(float x) { return 1.f / (1.f + __expf(-x)); }
DI float xhalf_max(float v) { unsigned u = __float_as_uint(v); auto rr = __builtin_amdgcn_permlane32_swap(u, u, false, false); return fmaxf(__uint_as_float(rr[0]), __uint_as_float(rr[1])); }
DI float xhalf_sum(float v) { unsigned u = __float_as_uint(v); auto rr = __builtin_amdgcn_permlane32_swap(u, u, false, false); return __uint_as_float(rr[0]) + __uint_as_float(rr[1]); }
DI void grid_barrier(unsigned* ctr, unsigned target) {
  __syncthreads();
  if (threadIdx.x == 0) {
    __threadfence();
    atomicAdd(ctr, 1u);
    while (__hip_atomic_load(ctr, __ATOMIC_RELAXED, __HIP_MEMORY_SCOPE_AGENT) < target) __builtin_amdgcn_s_sleep(4);
    __threadfence();
  }
  __syncthreads();
}
DI float wave_sum(float v) {
  v += __shfl_xor(v, 32); v += __shfl_xor(v, 16); v += __shfl_xor(v, 8); v += __shfl_xor(v, 4); v += __shfl_xor(v, 2); v += __shfl_xor(v, 1);
  return v;
}

constexpr int G_LDP = 72;
constexpr int G_STAGE = 512 * G_LDP;
template <class ASrc, class Epi>
DI void gemm_tile(ASrc asrc, const bf16_t* __restrict__ Bt, int ldb, int nk, int m0, int n0, Epi epi, bf16_t* lds) {
  const int tid = opaque_tid(), lane = tid & 63, w = tid >> 6, r = lane & 31, h = lane >> 5;
  const int wm = w >> 2, wn = w & 3;
  f32x16 acc[4][2];
#pragma unroll
  for (int mi = 0; mi < 4; ++mi)
#pragma unroll
    for (int ni = 0; ni < 2; ++ni)
#pragma unroll
      for (int i = 0; i < 16; ++i) acc[mi][ni][i] = 0.f;
  u32x4 ra[4], rb[4];
  const int lrow = tid >> 3, lch = tid & 7;
  auto gload = [&](int kt) {
    const bf16_t* ab; int as; asrc(kt, ab, as);
#pragma unroll
    for (int i = 0; i < 4; ++i) ra[i] = *(const u32x4*)(ab + (size_t)(m0 + lrow + 64 * i) * as + lch * 8);
#pragma unroll
    for (int i = 0; i < 4; ++i) rb[i] = *(const u32x4*)(Bt + (size_t)(n0 + lrow + 64 * i) * ldb + kt * 64 + lch * 8);
  };
  auto lstore = [&](int buf) {
    bf16_t* As = lds + buf * G_STAGE; bf16_t* Bs = As + 256 * G_LDP;
#pragma unroll
    for (int i = 0; i < 4; ++i) *(u32x4*)(As + (lrow + 64 * i) * G_LDP + lch * 8) = ra[i];
#pragma unroll
    for (int i = 0; i < 4; ++i) *(u32x4*)(Bs + (lrow + 64 * i) * G_LDP + lch * 8) = rb[i];
  };
  __syncthreads();
  gload(0);
  lstore(0);
  gload(1);
  for (int t = 0; t < nk; ++t) {
    __syncthreads();
    if (t + 1 < nk) lstore((t + 1) & 1);
    if (t + 2 < nk) gload(t + 2);
    const bf16_t* As = lds + (t & 1) * G_STAGE; const bf16_t* Bs = As + 256 * G_LDP;
#pragma unroll
    for (int ks = 0; ks < 4; ++ks) {
      bf16x8 a[4], b[2];
#pragma unroll
      for (int mi = 0; mi < 4; ++mi) a[mi] = *(const bf16x8*)(As + (wm * 128 + mi * 32 + r) * G_LDP + ks * 16 + 8 * h);
#pragma unroll
      for (int ni = 0; ni < 2; ++ni) b[ni] = *(const bf16x8*)(Bs + (wn * 64 + ni * 32 + r) * G_LDP + ks * 16 + 8 * h);
#pragma unroll
      for (int mi = 0; mi < 4; ++mi)
#pragma unroll
        for (int ni = 0; ni < 2; ++ni) acc[mi][ni] = MFMA(a[mi], b[ni], acc[mi][ni]);
    }
  }
#pragma unroll
  for (int mi = 0; mi < 4; ++mi)
#pragma unroll
    for (int ni = 0; ni < 2; ++ni) epi(m0 + wm * 128 + mi * 32, n0 + wn * 64 + ni * 32, acc[mi][ni]);
}

template <class ACol, class TileFn, class Epi>
DI void gemm_stream(const bf16_t* __restrict__ Abase, int as, ACol acol, const bf16_t* __restrict__ Bt, int ldb, int nk, TileFn tile_fn, Epi epi, bf16_t* lds) {
  const int tid = opaque_tid(), lane = tid & 63, w = tid >> 6, r = lane & 31, h = lane >> 5;
  const int wm = w >> 2, wn = w & 3;
  u32x4 ra[4], rb[4];
  const int lrow = tid >> 3, lch = tid & 7;
  const bf16_t* ap; const bf16_t* bp;
  auto gload = [&](int kt) {
    const int ac = acol(kt);
#pragma unroll
    for (int i = 0; i < 4; ++i) ra[i] = *(const u32x4*)(ap + (size_t)(64 * i) * as + ac);
#pragma unroll
    for (int i = 0; i < 4; ++i) rb[i] = *(const u32x4*)(bp + (size_t)(64 * i) * ldb + kt * 64);
  };
  auto lstore = [&](int buf) {
    bf16_t* As = lds + buf * G_STAGE; bf16_t* Bs = As + 256 * G_LDP;
#pragma unroll
    for (int i = 0; i < 4; ++i) *(u32x4*)(As + (lrow + 64 * i) * G_LDP + lch * 8) = ra[i];
#pragma unroll
    for (int i = 0; i < 4; ++i) *(u32x4*)(Bs + (lrow + 64 * i) * G_LDP + lch * 8) = rb[i];
  };
  int q = blockIdx.x >> 3; const int qstep = gridDim.x >> 3;
  int m0, n0;
  if (!tile_fn(q, m0, n0)) return;
  ap = Abase + (size_t)(m0 + lrow) * as + lch * 8; bp = Bt + (size_t)(n0 + lrow) * ldb + lch * 8;
  gload(0);
  while (true) {
    f32x16 acc[4][2];
#pragma unroll
    for (int mi = 0; mi < 4; ++mi)
#pragma unroll
      for (int ni = 0; ni < 2; ++ni)
#pragma unroll
        for (int i = 0; i < 16; ++i) acc[mi][ni][i] = 0.f;
    __syncthreads();
    lstore(0);
    gload(1);
    for (int t = 0; t < nk; ++t) {
      __syncthreads();
      const bf16_t* As = lds + (t & 1) * G_STAGE; const bf16_t* Bs = As + 256 * G_LDP;
      bf16_t* Asn = lds + ((t + 1) & 1) * G_STAGE; bf16_t* Bsn = Asn + 256 * G_LDP;
      const int ac2 = (t + 2 < nk) ? acol(t + 2) : 0;
#pragma unroll
      for (int ks = 0; ks < 4; ++ks) {
        bf16x8 a[4], b[2];
#pragma unroll
        for (int mi = 0; mi < 4; ++mi) a[mi] = *(const bf16x8*)(As + (wm * 128 + mi * 32 + r) * G_LDP + ks * 16 + 8 * h);
#pragma unroll
        for (int ni = 0; ni < 2; ++ni) b[ni] = *(const bf16x8*)(Bs + (wn * 64 + ni * 32 + r) * G_LDP + ks * 16 + 8 * h);
#pragma unroll
        for (int mi = 0; mi < 4; ++mi)
#pragma unroll
          for (int ni = 0; ni < 2; ++ni) acc[mi][ni] = MFMA(a[mi], b[ni], acc[mi][ni]);
        if (t + 1 < nk) {
          *(u32x4*)(Asn + (lrow + 64 * ks) * G_LDP + lch * 8) = ra[ks];
          *(u32x4*)(Bsn + (lrow + 64 * ks) * G_LDP + lch * 8) = rb[ks];
        }
        if (t + 2 < nk) {
          ra[ks] = *(const u32x4*)(ap + (size_t)(64 * ks) * as + ac2);
          rb[ks] = *(const u32x4*)(bp + (size_t)(64 * ks) * ldb + (t + 2) * 64);
        }
      }
    }
    q += qstep;
    int m1, n1;
    const bool v1 = tile_fn(q, m1, n1);
    if (v1) { ap = Abase + (size_t)(m1 + lrow) * as + lch * 8; bp = Bt + (size_t)(n1 + lrow) * ldb + lch * 8; gload(0); }
    epi(m0 + wm * 128, n0 + wn * 64, acc[0][0], acc[0][1]);
    epi(m0 + wm * 128 + 32, n0 + wn * 64, acc[1][0], acc[1][1]);
    epi(m0 + wm * 128 + 64, n0 + wn * 64, acc[2][0], acc[2][1]);
    epi(m0 + wm * 128 + 96, n0 + wn * 64, acc[3][0], acc[3][1]);
    if (!v1) break;
    m0 = m1; n0 = n1;
  }
}

DI bool xcd_tile(int q, int n_sub, int n_mt, int& mt, int& sub) {
  const int x = blockIdx.x & 7;
  const int mloc = q / n_sub; sub = q - mloc * n_sub;
  mt = mloc * 8 + x;
  return mt < n_mt;
}

template <class SrcFn>
DI void transpose64(SrcFn src, bf16_t* dst, int dld, int k0, int n0, float* tile) {
  const int tid = opaque_tid();
  __syncthreads();
  {
    const int nn = tid & 63, kq = tid >> 6;
#pragma unroll 4
    for (int i = 0; i < 8; ++i) { int kk = kq + 8 * i; tile[kk * 65 + nn] = src(k0 + kk, n0 + nn); }
  }
  __syncthreads();
  {
    const int kk2 = (tid & 31) * 2, nq = tid >> 5;
#pragma unroll 4
    for (int i = 0; i < 4; ++i) {
      int nn2 = nq + 16 * i;
      *(unsigned*)(dst + (size_t)(n0 + nn2) * dld + k0 + kk2) = pack2(tile[kk2 * 65 + nn2], tile[(kk2 + 1) * 65 + nn2]);
    }
  }
}

DI int win_perm(int n) {
  if (n < 2304) return n + 608;
  if (n < 2560) return n - 2304 + 352;
  if (n < 2752) return n - 2560;
  if (n < 2880) return n - 2752 + 192;
  if (n < 2912) return n - 2880 + 320;
  return -1;
}

DI void mod_item(const Params& p, int l, int nc, float* lds) {
  float* sc = lds;
  float* red = lds + 8192;
  const int tid = opaque_tid(), col = tid & 63, kq = tid >> 6;
  const int n = nc * 64 + col;
  float acc[32];
#pragma unroll
  for (int i = 0; i < 32; ++i) acc[i] = 0.f;
  const float* W = p.ada_w + (size_t)l * 1024 * 3072;
  for (int st = 0; st < 4; ++st) {
    __syncthreads();
    for (int e = 0; e < 16; ++e) {
      int idx = e * 512 + tid; int seq = idx >> 8, kk = idx & 255;
      const float* cp = seq < 16 ? p.c0 + seq * 1024 : p.c1 + (seq - 16) * 1024;
      sc[kk * 32 + seq] = silu_f(cp[st * 256 + kk]);
    }
    __syncthreads();
    for (int kk0 = 0; kk0 < 32; kk0 += 8) {
      float wv[8];
#pragma unroll
      for (int u = 0; u < 8; ++u) wv[u] = W[(size_t)(st * 256 + kq * 32 + kk0 + u) * 3072 + n];
#pragma unroll
      for (int u = 0; u < 8; ++u) {
        const float4* s4 = (const float4*)(sc + (kq * 32 + kk0 + u) * 32);
#pragma unroll
        for (int j = 0; j < 8; ++j) { float4 v = s4[j]; acc[4 * j] += v.x * wv[u]; acc[4 * j + 1] += v.y * wv[u]; acc[4 * j + 2] += v.z * wv[u]; acc[4 * j + 3] += v.w * wv[u]; }
      }
    }
  }
  __syncthreads();
#pragma unroll
  for (int i = 0; i < 32; ++i) red[(kq * 32 + i) * 64 + col] = acc[i];
  __syncthreads();
  float* modp = (float*)(p.ws + OFF_MOD) + (size_t)l * 32 * 3072;
  for (int e = 0; e < 4; ++e) {
    int seq = kq * 4 + e;
    float v = 0.f;
#pragma unroll
    for (int g = 0; g < 8; ++g) v += red[(g * 32 + seq) * 64 + col];
    modp[seq * 3072 + n] = v + p.ada_b[l * 3072 + n];
  }
  __syncthreads();
}

DI void phase0a(const Params& p, float* lds) {
  const int tid = opaque_tid();
  bf16_t* wt_in = (bf16_t*)(p.ws + OFF_WIN);
  bf16_t* wt_out = (bf16_t*)(p.ws + OFF_WOUT);
  bf16_t* wt_uq = (bf16_t*)(p.ws + OFF_WUQ);
  bf16_t* wt_ukv = (bf16_t*)(p.ws + OFF_WUKV);
  bf16_t* wlru = (bf16_t*)(p.ws + OFF_WLRU);
  constexpr int N_MOD = 96, N_WIN = 2 * 48 * 16, N_WOUT = 2 * 16 * 16, N_WUQ = 2 * 8 * 3, N_WUKV = 2 * 8 * 2, N_LRU = 32, N_TAB = 162;
  constexpr int N_ALL = N_MOD + N_WIN + N_WOUT + N_WUQ + N_WUKV + N_LRU + N_TAB + 1;
  for (int it = blockIdx.x; it < N_ALL; it += gridDim.x) {
    int j = it;
    if (j < N_MOD) { mod_item(p, j / 48, j % 48, lds); continue; }
    j -= N_MOD;
    if (j < N_WIN) {
      int l = j / (48 * 16), rem = j % (48 * 16), nt = rem / 16, kt = rem % 16;
      const float* src = p.w_in + (size_t)l * 1024 * NIN;
      transpose64([&](int k, int n) { int on = win_perm(n); return on >= 0 ? src[(size_t)k * NIN + on] : 0.f; },
                  wt_in + (size_t)l * 3072 * 1024, 1024, kt * 64, nt * 64, lds);
      continue;
    }
    j -= N_WIN;
    if (j < N_WOUT) {
      int l = j / (16 * 16), rem = j % (16 * 16), nt = rem / 16, kt = rem % 16;
      const float* src = p.w_out + (size_t)l * 1024 * 1024;
      transpose64([&](int k, int n) { return src[(size_t)k * 1024 + n]; },
                  wt_out + (size_t)l * 1024 * 1024, 1024, kt * 64, nt * 64, lds);
      continue;
    }
    j -= N_WOUT;
    if (j < N_WUQ) {
      int l = j / 24, rem = j % 24, nt = rem / 3, kt = rem % 3;
      const float* src = p.mla_w_uq + (size_t)l * 192 * 384;
      const float* gq = p.mla_q_norm + l * 192;
      transpose64([&](int k, int n) { return n < 384 ? src[(size_t)k * 384 + n] * gq[k] : 0.f; }, wt_uq + (size_t)l * 512 * 192, 192, kt * 64, nt * 64, lds);
      continue;
    }
    j -= N_WUQ;
    if (j < N_WUKV) {
      int l = j / 16, rem = j % 16, nt = rem / 2, kt = rem % 2;
      const float* src = p.mla_w_ukv + (size_t)l * 128 * 512;
      const float* gk = p.mla_kv_norm + l * 128;
      transpose64([&](int k, int n) { return src[(size_t)k * 512 + n] * gk[k]; }, wt_ukv + (size_t)l * 512 * 128, 128, kt * 64, nt * 64, lds);
      continue;
    }
    j -= N_WUKV;
    if (j < N_LRU) {
      int hh = j & 3, mat = (j >> 2) & 1, d = (j >> 3) & 1, l = j >> 4;
      const float* src = (mat ? p.lru_wx : p.lru_wa) + (size_t)((l * 2 + d) * 4 + hh) * 4096;
      transpose64([&](int k, int n) { return src[k * 64 + n]; }, wlru + (size_t)j * 4096, 64, 0, 0, lds);
      continue;
    }
    j -= N_LRU;
    if (j < N_TAB) {
      int e = j * 512 + tid;
      float2* tm = (float2*)(p.ws + OFF_TABM); float2* tp = (float2*)(p.ws + OFF_TABP); float2* tx = (float2*)(p.ws + OFF_TABX);
      if (e < 65536) { int pos = e >> 4, f = e & 15; float inv = powf(10000.f, -(float)f / 16.f); float a = (float)pos * inv; tm[e] = make_float2(cosf(a), sinf(a)); }
      else if (e < 65536 + 16384) { int q = e - 65536; int pos = q >> 2, f = q & 3; float inv = powf(500000.f, -(float)f / 4.f); float a = (float)pos * inv; tp[q] = make_float2(cosf(a), sinf(a)); }
      else if (e < 65536 + 16384 + 1024) { int q = e - 65536 - 16384; int pos = q >> 4, f = q & 15; float inv = powf(10000.f, -(float)f / 16.f); float a = (float)pos * inv; tx[q] = make_float2(cosf(a), sinf(a)); }
      continue;
    }
    if (tid < 2) {
      int l = tid; const float* lf = p.diff_lambda + l * 128;
      float s1 = 0.f, s2 = 0.f;
      for (int i = 0; i < 32; ++i) { s1 += lf[i] * lf[32 + i]; s2 += lf[64 + i] * lf[96 + i]; }
      float lam_init = 0.8f - 0.6f * expf(-0.3f * (float)l);
      ((float*)(p.ws + OFF_LAM))[l] = expf(s1) - expf(s2) + lam_init;
    }
  }
}

DI void phase_norm(const Params& p, int l, int mode, bool from_input) {
  using f32x4 = __attribute__((ext_vector_type(4))) float;
  const int tid = opaque_tid(), lane = tid & 63, w = tid >> 6;
  bf16_t* hbuf = (bf16_t*)(p.ws + OFF_H);
  const float* modp = (const float*)(p.ws + OFF_MOD) + (size_t)l * 32 * 3072;
  const float* g = mode == 0 ? p.norm_g + l * 1024 : p.final_norm;
  for (int it = blockIdx.x; it < T_TOK / 32; it += gridDim.x) {
    const int t0 = it * 32 + w * 4;
    const float* xr0 = from_input ? (t0 < T_P ? p.xin0 + (size_t)t0 * 1024 : p.xin1 + (size_t)(t0 - T_P) * 1024) : p.out + (size_t)t0 * 1024;
    f32x4 v[4][4];
#pragma unroll
    for (int rr = 0; rr < 4; ++rr)
#pragma unroll
      for (int j = 0; j < 4; ++j) v[rr][j] = *(const f32x4*)(xr0 + rr * 1024 + j * 256 + lane * 4);
    f32x4 gs[4], sh4[4];
    {
      int seq, s; tok2seq(t0, seq, s);
      const float* sh = modp + seq * 3072; const float* scl = sh + 1024;
#pragma unroll
      for (int j = 0; j < 4; ++j) {
        const int k = j * 256 + lane * 4;
        f32x4 gg = *(const f32x4*)(g + k);
        if (mode == 0) { f32x4 s4 = *(const f32x4*)(scl + k); gs[j] = gg * (1.f + s4); sh4[j] = *(const f32x4*)(sh + k); }
        else { gs[j] = gg; sh4[j] = gg * 0.f; }
      }
    }
#pragma unroll
    for (int rr = 0; rr < 4; ++rr) {
      float ss = 0.f;
#pragma unroll
      for (int j = 0; j < 4; ++j) ss += v[rr][j].x * v[rr][j].x + v[rr][j].y * v[rr][j].y + v[rr][j].z * v[rr][j].z + v[rr][j].w * v[rr][j].w;
      ss = wave_sum(ss);
      const float rstd = rsqrtf(ss * (1.f / 1024.f) + EPSN);
      const int t = t0 + rr;
#pragma unroll
      for (int j = 0; j < 4; ++j) {
        const int k = j * 256 + lane * 4;
        f32x4 o = v[rr][j] * rstd * gs[j] + sh4[j];
        if (mode == 0) {
          u32x2 ou = {pack2(o.x, o.y), pack2(o.z, o.w)};
          *(u32x2*)(hbuf + (size_t)t * 1024 + k) = ou;
        } else {
          *(f32x4*)(p.out + (size_t)t * 1024 + k) = o;
        }
      }
    }
  }
}

DI void phase_inproj(const Params& p, int l, bf16_t* lds) {
  const bf16_t* hbuf = (const bf16_t*)(p.ws + OFF_H);
  const bf16_t* wt = (const bf16_t*)(p.ws + OFF_WIN) + (size_t)l * 3072 * 1024;
  bf16_t* z = (bf16_t*)(p.ws + OFF_Z);
  bf16_t* vtb = (bf16_t*)(p.ws + OFF_VTB);
  bf16_t* vtd = (bf16_t*)(p.ws + OFF_VTD);
  float* rss = (float*)(p.ws + OFF_RSS);
  const float2* tm = (const float2*)(p.ws + OFF_TABM); const float2* tp = (const float2*)(p.ws + OFF_TABP); const float2* tx = (const float2*)(p.ws + OFF_TABX);
  const float SCB = 0.17677669529663687f * LOG2E;
  const float SCD = 0.125f * LOG2E;
  constexpr int NT = 12, MT = T_TOK / 256;
  {
    gemm_stream(hbuf, 1024, [&](int kt) { return kt * 64; }, wt, 1024, 16,
              [&](int q, int& tm0, int& tn0) { int mt, nt; const bool v = xcd_tile(q, NT, MT, mt, nt); nt = (nt + (mt >> 3)) % NT; tm0 = mt * 256; tn0 = nt * 256; return v; },
              [&](int m0, int n64, const f32x16& acc0, const f32x16& acc1) {
                const int lane = opaque_tid() & 63, r = lane & 31, h = lane >> 5;
                int seq, s0; tok2seq(m0, seq, s0);
                const int S = seq_len(seq), st = seq_start(seq);
                auto store_strip = [&](float a, float b, int i) {
                  auto rr = __builtin_amdgcn_permlane32_swap(__float_as_uint(a), __float_as_uint(b), false, false);
                  bf16_t* zp = z + (size_t)(m0 + (i & 3) + 8 * (i >> 2)) * ZS + n64 + lane;
                  zp[0] = f2bf(__uint_as_float(rr[0])); zp[(size_t)4 * ZS] = f2bf(__uint_as_float(rr[1]));
                };
                if (n64 >= ZC_QD && n64 < ZC_VD) {
                  const bool isq = n64 < ZC_KD;
                  const float* gn = (isq ? p.gqa_q_norm : p.gqa_k_norm) + l * 64;
                  const float g0 = gn[r], g1 = gn[32 + r];
                  const float scl = isq ? SCD : 1.f;
#pragma unroll
                  for (int i = 0; i < 16; ++i) {
                    float ss = acc0[i] * acc0[i] + acc1[i] * acc1[i];
                    ss += __shfl_xor(ss, 1); ss += __shfl_xor(ss, 2); ss += __shfl_xor(ss, 4); ss += __shfl_xor(ss, 8); ss += __shfl_xor(ss, 16);
                    const float rstd = rsqrtf(ss * (1.f / 64.f) + EPSN);
                    const int sp = s0 + crow(i, h);
                    const float x0 = acc0[i] * rstd * g0, x1 = acc1[i] * rstd * g1;
                    const float p0 = __shfl_xor(x0, 16), p1 = __shfl_xor(x1, 16);
                    const float2 c0 = tx[(sp >> 6) * 16 + (r & 15)], c1 = tx[(sp & 63) * 16 + (r & 15)];
                    const float o0 = (r < 16 ? x0 * c0.x - p0 * c0.y : x0 * c0.x + p0 * c0.y) * scl;
                    const float o1 = (r < 16 ? x1 * c1.x - p1 * c1.y : x1 * c1.x + p1 * c1.y) * scl;
                    store_strip(o0, o1, i);
                  }
                }
                if (n64 >= ZC_QA && n64 < ZC_KRA) {
                  float* rs = rss + (size_t)(m0 + 4 * h) * 8 + ((n64 - ZC_QA) >> 6);
#pragma unroll
                  for (int i = 0; i < 16; ++i) {
                    float ss = acc0[i] * acc0[i] + acc1[i] * acc1[i];
                    ss += __shfl_xor(ss, 1); ss += __shfl_xor(ss, 2); ss += __shfl_xor(ss, 4); ss += __shfl_xor(ss, 8); ss += __shfl_xor(ss, 16);
                    if (r == 0) rs[((i & 3) + 8 * (i >> 2)) * 8] = ss;
                  }
                }
                if (n64 < ZC_VB) {
                  const float scl = n64 < ZC_KB ? SCB : 1.f;
#pragma unroll
                  for (int i = 0; i < 16; ++i) {
                    const float xa = acc0[i], xb2 = acc1[i];
                    const float pa = __shfl_xor(xa, 4), pb = __shfl_xor(xb2, 4);
                    const float2 cs = tp[(s0 + crow(i, h)) * 4 + (r & 3)];
                    const float oa = r < 4 ? xa * cs.x - pa * cs.y : (r < 8 ? xa * cs.x + pa * cs.y : xa);
                    const float ob2 = r < 4 ? xb2 * cs.x - pb * cs.y : (r < 8 ? xb2 * cs.x + pb * cs.y : xb2);
                    store_strip(oa * scl, ob2 * scl, i);
                  }
                }
                if ((n64 >= ZC_GB && n64 < ZC_QD) || (n64 >= ZC_GD && n64 < ZC_KRA)) {
#pragma unroll
                  for (int i = 0; i < 16; ++i) {
                    float a = acc0[i], b = acc1[i];
                    asm volatile("" : "+v"(a), "+v"(b));
                    store_strip(a, b, i);
                  }
                }
                auto tile_epi = [&](const f32x16& acc, const int n0) {
                  const int n = n0 + r;
                  if (n0 >= ZC_VB && n0 < ZC_GB) {
                    bf16_t* base = vtb + (size_t)st * 256 + (size_t)(n - ZC_VB) * S + s0;
#pragma unroll
                    for (int g4 = 0; g4 < 4; ++g4)
                      *(uint2*)(base + 8 * g4 + 4 * h) = make_uint2(pack2(acc[4 * g4], acc[4 * g4 + 1]), pack2(acc[4 * g4 + 2], acc[4 * g4 + 3]));
                  } else if (n0 >= ZC_VD && n0 < ZC_GD) {
                    bf16_t* base = vtd + (size_t)st * 128 + (size_t)(n - ZC_VD) * S + s0;
#pragma unroll
                    for (int g4 = 0; g4 < 4; ++g4)
                      *(uint2*)(base + 8 * g4 + 4 * h) = make_uint2(pack2(acc[4 * g4], acc[4 * g4 + 1]), pack2(acc[4 * g4 + 2], acc[4 * g4 + 3]));
                  } else if (n0 < ZC_VB) {
                    const float scl = n0 < ZC_KB ? SCB : 1.f;
#pragma unroll
                    for (int i = 0; i < 16; ++i) {
                      const float x = acc[i];
                      const float pr = __shfl_xor(x, 4);
                      const float2 cs = tp[(s0 + crow(i, h)) * 4 + (r & 3)];
                      const float o = r < 4 ? x * cs.x - pr * cs.y : (r < 8 ? x * cs.x + pr * cs.y : x);
                      z[(size_t)(m0 + crow(i, h)) * ZS + n] = f2bf(o * scl);
                    }
                  } else if (n0 == ZC_KRA) {
#pragma unroll
                    for (int i = 0; i < 16; ++i) {
                      const float x = acc[i];
                      const float pr = __shfl_xor(x, 16);
                      const float2 cs = tm[(s0 + crow(i, h)) * 16 + (r & 15)];
                      z[(size_t)(m0 + crow(i, h)) * ZS + n] = f2bf(r < 16 ? x * cs.x - pr * cs.y : x * cs.x + pr * cs.y);
                    }
                  } else if (n0 < NIN) {
#pragma unroll
                    for (int i = 0; i < 16; ++i) z[(size_t)(m0 + crow(i, h)) * ZS + n] = f2bf(acc[i]);
                  }
                };
                const bool strip_done = (n64 >= ZC_QD && n64 < ZC_VD) || n64 < ZC_VB || (n64 >= ZC_GB && n64 < ZC_QD) || (n64 >= ZC_GD && n64 < ZC_KRA);
                if (!strip_done) { tile_epi(acc0, n64); tile_epi(acc1, n64 + 32); }
              },
              lds);
  }
}

DI void phase_mla_up(const Params& p, int l, bf16_t* lds) {
  const bf16_t* z = (const bf16_t*)(p.ws + OFF_Z);
  bf16_t* QA = (bf16_t*)(p.ws + OFF_QA);
  bf16_t* KA = (bf16_t*)(p.ws + OFF_KA);
  bf16_t* VTA = (bf16_t*)(p.ws + OFF_VTA);
  const bf16_t* wuq = (const bf16_t*)(p.ws + OFF_WUQ) + (size_t)l * 512 * 192;
  const bf16_t* wukv = (const bf16_t*)(p.ws + OFF_WUKV) + (size_t)l * 512 * 128;
  const float2* tm = (const float2*)(p.ws + OFF_TABM);
  const float* rss = (const float*)(p.ws + OFF_RSS);
  const int lane = opaque_tid() & 63, r = lane & 31, h = lane >> 5;
  const float SCA = 0.10206207261596577f * LOG2E;
  constexpr int MT = T_TOK / 256;
  for (int q = blockIdx.x >> 3;; q += gridDim.x >> 3) {
    int mt, sub;
    if (!xcd_tile(q, 4, MT, mt, sub)) break;
    sub = (sub + (mt >> 6)) & 3;
    if (sub < 2) {
      gemm_tile([&](int kt, const bf16_t*& ab, int& as) { ab = z + ZC_QA + kt * 64; as = ZS; }, wuq, 192, 3, mt * 256, sub * 256,
                [&](int m0, int n0, const f32x16& acc) {
                  if (n0 >= 384) return;
                  const int n = n0 + r;
                  const bool pe = ((n0 >> 5) % 3) == 2;
                  int seq, s0; tok2seq(m0, seq, s0);
#pragma unroll
                  for (int i = 0; i < 16; ++i) {
                    const float* rs = rss + (size_t)(m0 + crow(i, h)) * 8;
                    float x = acc[i] * rsqrtf((rs[0] + rs[1] + rs[2]) * (1.f / 192.f) + EPSN);
                    if (pe) {
                      float pr = __shfl_xor(x, 16);
                      float2 cs = tm[(s0 + crow(i, h)) * 16 + (r & 15)];
                      x = (r < 16) ? x * cs.x - pr * cs.y : x * cs.x + pr * cs.y;
                    }
                    QA[(size_t)(m0 + crow(i, h)) * 384 + n] = f2bf(x * SCA);
                  }
                },
                lds);
    } else {
      gemm_tile([&](int kt, const bf16_t*& ab, int& as) { ab = z + ZC_KVA + kt * 64; as = ZS; }, wukv, 128, 2, mt * 256, (sub - 2) * 256,
                [&](int m0, int n0, const f32x16& acc) {
                  const int hh = n0 >> 7;
                  const int nn = (n0 & 127) + r;
                  auto rstd_of = [&](int i) { const float* rs = rss + (size_t)(m0 + crow(i, h)) * 8; return rsqrtf((rs[3] + rs[4]) * (1.f / 128.f) + EPSN); };
                  if (nn < 64) {
#pragma unroll
                    for (int i = 0; i < 16; ++i) KA[(size_t)(m0 + crow(i, h)) * 384 + hh * 96 + nn] = f2bf(acc[i] * rstd_of(i));
                    if (nn >= 32) {
#pragma unroll
                      for (int i = 0; i < 16; ++i) KA[(size_t)(m0 + crow(i, h)) * 384 + hh * 96 + 64 + r] = z[(size_t)(m0 + crow(i, h)) * ZS + ZC_KRA + r];
                    }
                  } else {
                    int seq, s; tok2seq(m0, seq, s); const int S = seq_len(seq), st = seq_start(seq);
                    bf16_t* base = VTA + (size_t)st * 256 + (size_t)(hh * 64 + nn - 64) * S + s;
#pragma unroll
                    for (int g4 = 0; g4 < 4; ++g4)
                      *(uint2*)(base + 8 * g4 + 4 * h) = make_uint2(pack2(acc[4 * g4] * rstd_of(4 * g4), acc[4 * g4 + 1] * rstd_of(4 * g4 + 1)), pack2(acc[4 * g4 + 2] * rstd_of(4 * g4 + 2), acc[4 * g4 + 3] * rstd_of(4 * g4 + 3)));
                  }
                },
                lds);
    }
  }
}

template <int DK, int KW, bool DIFF>
DI void attn_item(const bf16_t* qp, int qstride, const bf16_t* kp, int kstride, const bf16_t* vt, bf16_t* op, int ostride, const bf16_t* gp,
                  int S, int start, int qt, bf16_t* lds, float lam, float post_scale, const float* subln) {
  constexpr int KWP = KW + 8;
  constexpr int KCH = KW / 8;
  constexpr int KLD = (64 * KCH + 511) / 512;
  constexpr int NKS = DK / 16;
  bf16_t* Ks = lds;
  bf16_t* Vs = lds + 2 * 64 * KWP;
  float* Xc = (float*)(lds + 2 * 64 * KWP + 2 * 64 * 72);
  const int tid = opaque_tid(), lane = tid & 63, w = tid >> 6, r = lane & 31, h = lane >> 5;
  const int sub = DIFF ? (w >> 2) : 0;
  const int rblk = DIFF ? (w & 3) : w;
  const int koff = DIFF ? sub * DK : 0;
  const int qrow = start + qt * (DIFF ? 128 : 256) + rblk * 32 + r;
  bf16x8 qf[NKS];
#pragma unroll
  for (int ks = 0; ks < NKS; ++ks) qf[ks] = *(const bf16x8*)(qp + (size_t)qrow * qstride + koff + ks * 16 + 8 * h);
  constexpr bool USE_NM = (DK < 96);
  f32x16 O[2], NM;
  float lrun = 0.f, mref = 0.f;
#pragma unroll
  for (int e = 0; e < 16; ++e) { O[0][e] = 0.f; O[1][e] = 0.f; NM[e] = 0.f; }
  u32x4 kreg[KLD], vreg;
  const int vrow = tid >> 3, vch = tid & 7;
  const int nt = S / 64;
  auto gloadK = [&](int t) {
#pragma unroll
    for (int i = 0; i < KLD; ++i) { int q = tid + 512 * i; int row = q / KCH, c = q % KCH; if (q < 64 * KCH) kreg[i] = *(const u32x4*)(kp + (size_t)(start + t * 64 + row) * kstride + c * 8); }
  };
  auto gloadV = [&](int t) { vreg = *(const u32x4*)(vt + (size_t)vrow * S + t * 64 + vch * 8); };
  auto storeK = [&](int buf) {
    bf16_t* kbn = Ks + buf * 64 * KWP;
#pragma unroll
    for (int i = 0; i < KLD; ++i) { int q = tid + 512 * i; int row = q / KCH, c = q % KCH; if (q < 64 * KCH) *(u32x4*)(kbn + row * KWP + c * 8) = kreg[i]; }
  };
  auto storeV = [&](int buf) {
    bf16_t* vbn = Vs + buf * 64 * 72;
    u32x2 lo2 = {vreg.x, vreg.y}; u32x2 hi2 = {vreg.z, vreg.w};
    bf16_t* dst = vbn + vrow * 72 + (vch >> 1) * 16 + (vch & 1) * 4;
    *(u32x2*)dst = lo2; *(u32x2*)(dst + 8) = hi2;
  };
  __syncthreads();
  gloadK(0); gloadV(0); storeK(0); storeV(0);
  gloadK(1); storeK(1);
  __syncthreads();
  f32x16 sc[2];
#pragma unroll
  for (int kb2 = 0; kb2 < 2; ++kb2) {
    sc[kb2] = NM;
#pragma unroll
    for (int ks = 0; ks < NKS; ++ks) {
      bf16x8 a = *(const bf16x8*)(Ks + (kb2 * 32 + r) * KWP + koff + ks * 16 + 8 * h);
      sc[kb2] = MFMA(a, qf[ks], sc[kb2]);
    }
  }
  if (w >= 4) __builtin_amdgcn_s_setprio(1);
  for (int t = 0; t < nt; ++t) {
    if (t + 2 < nt) gloadK(t + 2);
    if (t + 1 < nt) gloadV(t + 1);
    const bf16_t* kbn = Ks + ((t + 1) & 1) * 64 * KWP; const bf16_t* vb = Vs + (t & 1) * 64 * 72;
    u32x4 vf[2][4];
#pragma unroll
    for (int dvb = 0; dvb < 2; ++dvb)
#pragma unroll
      for (int c4 = 0; c4 < 2; ++c4) {
        vf[dvb][c4] = *(const u32x4*)(vb + (dvb * 32 + r) * 72 + c4 * 16 + 8 * h);
      }
    __builtin_amdgcn_sched_barrier(0);
    unsigned u0 = __float_as_uint(sc[0][0]), u1 = __float_as_uint(sc[0][1]), u2 = __float_as_uint(sc[1][0]), u3 = __float_as_uint(sc[1][1]);
#pragma unroll
    for (int e = 2; e < 16; e += 2) {
      u0 = min(u0, min(__float_as_uint(sc[0][e]), __float_as_uint(sc[0][e + 1])));
      u1 = min(u1, min(__float_as_uint(sc[1][e]), __float_as_uint(sc[1][e + 1])));
    }
    u0 = min(min(u0, u1), min(u2, u3));
    {
      auto rr = __builtin_amdgcn_permlane32_swap(u0, u0, false, false);
      u0 = min((unsigned)rr[0], (unsigned)rr[1]);
    }
    const float REF_GAP = 8.f;
    const float rel = USE_NM ? 0.f : mref;
    const bool grow = (u0 < 0x80000000u) || (__uint_as_float(u0) - rel > -2.f);
    if (t == 0 || __any(grow)) {
      float m0 = fmaxf(sc[0][0], sc[0][1]), m1 = fmaxf(sc[0][2], sc[0][3]), m2 = fmaxf(sc[1][0], sc[1][1]), m3 = fmaxf(sc[1][2], sc[1][3]);
#pragma unroll
      for (int e = 4; e < 16; e += 4) {
        m0 = fmaxf(m0, fmaxf(sc[0][e], sc[0][e + 1])); m1 = fmaxf(m1, fmaxf(sc[0][e + 2], sc[0][e + 3]));
        m2 = fmaxf(m2, fmaxf(sc[1][e], sc[1][e + 1])); m3 = fmaxf(m3, fmaxf(sc[1][e + 2], sc[1][e + 3]));
      }
      const float mx = xhalf_max(fmaxf(fmaxf(m0, m1), fmaxf(m2, m3))) - rel;
      const float delta = (t == 0) ? mx + REF_GAP : fmaxf(mx + REF_GAP, 0.f);
      const float corr = __builtin_amdgcn_exp2f(-delta);
      lrun *= corr;
      mref += delta;
#pragma unroll
      for (int e = 0; e < 16; ++e) {
        if (USE_NM) { sc[0][e] -= delta; sc[1][e] -= delta; NM[e] -= delta; }
        O[0][e] *= corr; O[1][e] *= corr;
      }
    }
    float p0 = 0.f, p1 = 0.f, p2 = 0.f, p3 = 0.f;
    bf16x8 pf[4];
#pragma unroll
    for (int kb2 = 0; kb2 < 2; ++kb2)
#pragma unroll
      for (int s2 = 0; s2 < 2; ++s2) {
        float a[8];
#pragma unroll
        for (int e = 0; e < 8; ++e) a[e] = __builtin_amdgcn_exp2f(USE_NM ? sc[kb2][8 * s2 + e] : sc[kb2][8 * s2 + e] - mref);
        p0 += a[0] + a[4]; p1 += a[1] + a[5]; p2 += a[2] + a[6]; p3 += a[3] + a[7];
        u32x4 pu = {pack2(a[0], a[1]), pack2(a[2], a[3]), pack2(a[4], a[5]), pack2(a[6], a[7])};
        pf[kb2 * 2 + s2] = __builtin_bit_cast(bf16x8, pu);
      }
    lrun += (p0 + p1) + (p2 + p3);
    bf16x8 kf0[NKS], kf1[NKS];
#pragma unroll
    for (int ks = 0; ks < NKS; ++ks) kf0[ks] = *(const bf16x8*)(kbn + r * KWP + koff + ks * 16 + 8 * h);
    __builtin_amdgcn_sched_barrier(0);
#pragma unroll
    for (int c4 = 0; c4 < 2; ++c4)
#pragma unroll
      for (int dvb = 0; dvb < 2; ++dvb) O[dvb] = MFMA(__builtin_bit_cast(bf16x8, vf[dvb][c4]), pf[c4], O[dvb]);
#pragma unroll
    for (int dvb = 0; dvb < 2; ++dvb)
#pragma unroll
      for (int c4 = 2; c4 < 4; ++c4) {
        vf[dvb][c4] = *(const u32x4*)(vb + (dvb * 32 + r) * 72 + c4 * 16 + 8 * h);
      }
#pragma unroll
    for (int ks = 0; ks < NKS; ++ks) kf1[ks] = *(const bf16x8*)(kbn + (32 + r) * KWP + koff + ks * 16 + 8 * h);
    __builtin_amdgcn_sched_barrier(0);
    sc[0] = NM; sc[1] = NM;
#pragma unroll
    for (int ks = 0; ks < NKS; ++ks) sc[0] = MFMA(kf0[ks], qf[ks], sc[0]);
#pragma unroll
    for (int c4 = 2; c4 < 4; ++c4)
#pragma unroll
      for (int dvb = 0; dvb < 2; ++dvb) O[dvb] = MFMA(__builtin_bit_cast(bf16x8, vf[dvb][c4]), pf[c4], O[dvb]);
#pragma unroll
    for (int ks = 0; ks < NKS; ++ks) sc[1] = MFMA(kf1[ks], qf[ks], sc[1]);
    if (t + 2 < nt) storeK(t & 1);
    if (t + 1 < nt) storeV((t + 1) & 1);
    __syncthreads();
  }
  __builtin_amdgcn_s_setprio(0);
  const float lt = xhalf_sum(lrun);
  const float inv = 1.f / lt;
  if (DIFF) {
    if (sub == 1) {
#pragma unroll
      for (int dvb = 0; dvb < 2; ++dvb)
#pragma unroll
        for (int e = 0; e < 16; ++e) Xc[(rblk * 64 + dvb * 32 + crow(e, h)) * 32 + r] = O[dvb][e] * inv;
    }
    __syncthreads();
    if (sub == 0) {
      float ss = 0.f;
#pragma unroll
      for (int dvb = 0; dvb < 2; ++dvb)
#pragma unroll
        for (int e = 0; e < 16; ++e) { float v = O[dvb][e] * inv - lam * Xc[(rblk * 64 + dvb * 32 + crow(e, h)) * 32 + r]; O[dvb][e] = v; ss += v * v; }
      ss = xhalf_sum(ss);
      const float rstd = rsqrtf(ss * (1.f / 64.f) + EPSN) * post_scale;
#pragma unroll
      for (int dvb = 0; dvb < 2; ++dvb)
#pragma unroll
        for (int g4 = 0; g4 < 4; ++g4) {
          const int dv = dvb * 32 + 8 * g4 + 4 * h;
          u32x2 gu = *(const u32x2*)(gp + (size_t)qrow * ZS + dv);
          float g0 = silu_f(bflo(gu.x)), g1 = silu_f(bfhi(gu.x)), g2 = silu_f(bflo(gu.y)), g3 = silu_f(bfhi(gu.y));
          float o0 = O[dvb][4 * g4] * rstd * subln[dv] * g0, o1 = O[dvb][4 * g4 + 1] * rstd * subln[dv + 1] * g1;
          float o2 = O[dvb][4 * g4 + 2] * rstd * subln[dv + 2] * g2, o3 = O[dvb][4 * g4 + 3] * rstd * subln[dv + 3] * g3;
          u32x2 ou = {pack2(o0, o1), pack2(o2, o3)};
          *(u32x2*)(op + (size_t)qrow * ostride + dv) = ou;
        }
    }
  } else {
#pragma unroll
    for (int dvb = 0; dvb < 2; ++dvb)
#pragma unroll
      for (int g4 = 0; g4 < 4; ++g4) {
        const int dv = dvb * 32 + 8 * g4 + 4 * h;
        u32x2 gu = *(const u32x2*)(gp + (size_t)qrow * ZS + dv);
        float g0 = silu_f(bflo(gu.x)), g1 = silu_f(bfhi(gu.x)), g2 = silu_f(bflo(gu.y)), g3 = silu_f(bfhi(gu.y));
        float o0 = O[dvb][4 * g4] * inv * g0, o1 = O[dvb][4 * g4 + 1] * inv * g1;
        float o2 = O[dvb][4 * g4 + 2] * inv * g2, o3 = O[dvb][4 * g4 + 3] * inv * g3;
        u32x2 ou = {pack2(o0, o1), pack2(o2, o3)};
        *(u32x2*)(op + (size_t)qrow * ostride + dv) = ou;
      }
  }
}

DI void scan_item(const Params& p, int l, int seq, int hh, char* ldsraw0) {
  const int tid512 = opaque_tid();
  const int dir = tid512 >> 8;
  char* ldsraw = ldsraw0 + dir * 61440;
  bf16_t* Xs = (bf16_t*)ldsraw;
  float* Xf = (float*)(ldsraw + 9216);
  float* Aa = Xf + 4096;
  float* Bb = Aa + 4096;
  float* SegA = Bb + 4096;
  float* SegB = SegA + 256;
  float* carry = SegB + 256;
  const int tid = tid512 & 255, lane = tid & 63, w = tid >> 6, r = lane & 31, h = lane >> 5;
  const int mi = w >> 1, ni = w & 1;
  const int S = seq_len(seq), start = seq_start(seq);
  const bf16_t* z = (const bf16_t*)(p.ws + OFF_Z);
  bf16_t* zw = (bf16_t*)(p.ws + OFF_Z);
  bf16_t* hfb = (bf16_t*)(p.ws + OFF_HFB);
  const bf16_t* wl = (const bf16_t*)(p.ws + OFF_WLRU);
  bf16x8 wf[2][4];
#pragma unroll
  for (int mat = 0; mat < 2; ++mat)
#pragma unroll
    for (int ks = 0; ks < 4; ++ks)
      wf[mat][ks] = *(const bf16x8*)(wl + (size_t)((((l * 2 + dir) * 2 + mat) * 4 + hh) * 64 + ni * 32 + r) * 64 + ks * 16 + 8 * h);
  const int che = hh * 64 + ni * 32 + r;
  const float ba = p.lru_ba[(l * 2 + dir) * 256 + che], bx = p.lru_bx[(l * 2 + dir) * 256 + che];
  const float sp8 = 8.f * log1pf(expf(-p.lru_lambda[(l * 2 + dir) * 256 + che]));
  const int c = tid & 63, q = tid >> 6;
  const int chs = hh * 64 + c;
  const float cw0 = p.conv_w[(l * 4 + 0) * 256 + chs], cw1 = p.conv_w[(l * 4 + 1) * 256 + chs], cw2 = p.conv_w[(l * 4 + 2) * 256 + chs], cw3 = p.conv_w[(l * 4 + 3) * 256 + chs];
  const float cb = p.conv_b[l * 256 + chs];
  __syncthreads();
  if (tid < 128) carry[tid] = 0.f;
  const int ntile = S / 64;
  const bf16_t* zx = z + (size_t)start * ZS + ZC_XC + chs;
  const bf16_t* zg = z + (size_t)start * ZS + ZC_GC + chs;
  bf16_t xn[19];
  {
    const int sb = (dir ? S - 64 : 0) + q * 16 - 2;
#pragma unroll
    for (int e = 0; e < 19; ++e) { int sp = sb + e; xn[e] = (sp >= 0 && sp < S) ? zx[(size_t)sp * ZS] : (bf16_t)0; }
  }
  for (int tile = 0; tile < ntile; ++tile) {
    const int p0 = dir ? S - 64 * (tile + 1) : 64 * tile;
    float xv[19];
#pragma unroll
    for (int e = 0; e < 19; ++e) xv[e] = bf2f(xn[e]);
    if (tile + 1 < ntile) {
      const int sb = (dir ? S - 64 * (tile + 2) : 64 * (tile + 1)) + q * 16 - 2;
#pragma unroll
      for (int e = 0; e < 19; ++e) { int sp = sb + e; xn[e] = (sp >= 0 && sp < S) ? zx[(size_t)sp * ZS] : (bf16_t)0; }
    }
    const bool first = tile < (ntile >> 1);
    unsigned gp[16];
    if (!first) {
#pragma unroll
      for (int jj = 0; jj < 16; ++jj) {
        const int u = q * 16 + jj; const int tok = dir ? 63 - u : u;
        gp[jj] = (unsigned)zg[(size_t)(p0 + tok) * ZS] | ((unsigned)hfb[(size_t)(start + p0 + tok) * 512 + (1 - dir) * 256 + chs] << 16);
      }
    }
#pragma unroll
    for (int jj = 0; jj < 16; ++jj) {
      float xc = cb + cw0 * xv[jj] + cw1 * xv[jj + 1] + cw2 * xv[jj + 2] + cw3 * xv[jj + 3];
      Xs[(q * 16 + jj) * 72 + c] = f2bf(xc);
      Xf[(q * 16 + jj) * 64 + c] = xc;
    }
    __syncthreads();
    {
      f32x16 aR, aI;
#pragma unroll
      for (int e = 0; e < 16; ++e) { aR[e] = 0.f; aI[e] = 0.f; }
#pragma unroll
      for (int ks = 0; ks < 4; ++ks) {
        bf16x8 a = *(const bf16x8*)(Xs + (mi * 32 + r) * 72 + ks * 16 + 8 * h);
        aR = MFMA(a, wf[0][ks], aR);
        aI = MFMA(a, wf[1][ks], aI);
      }
#pragma unroll
      for (int i = 0; i < 16; ++i) {
        const int tok = mi * 32 + crow(i, h), ch = ni * 32 + r;
        const float rr = __builtin_amdgcn_rcpf(1.f + __expf(-(aR[i] + ba)));
        const float ii = __builtin_amdgcn_rcpf(1.f + __expf(-(aI[i] + bx)));
        const float xq = Xf[tok * 64 + ch];
        const float log_a = -sp8 * rr;
        const float a = __expf(log_a);
        const float x2 = 2.f * log_a;
        const float ser = -x2 * (1.f + x2 * (0.5f + x2 * (0.16666667f + x2 * 0.041666668f)));
        const float om = x2 > -0.1f ? ser : 1.f - __expf(x2);
        const float gx = __builtin_amdgcn_sqrtf(om) * (ii * xq);
        Aa[tok * 64 + ch] = a; Bb[tok * 64 + ch] = gx;
      }
    }
    __syncthreads();
    float Ac[16], Bc[16];
    {
      float A = 1.f, B = 0.f;
#pragma unroll
      for (int jj = 0; jj < 16; ++jj) {
        const int u = q * 16 + jj; const int tok = dir ? 63 - u : u;
        float a = Aa[tok * 64 + c], b = Bb[tok * 64 + c];
        B = a * B + b; A = A * a; Ac[jj] = A; Bc[jj] = B;
      }
      SegA[q * 64 + c] = A; SegB[q * 64 + c] = B;
    }
    __syncthreads();
    {
      float cin = carry[(tile & 1) * 64 + c];
      for (int qq = 0; qq < q; ++qq) cin = SegA[qq * 64 + c] * cin + SegB[qq * 64 + c];
#pragma unroll
      for (int jj = 0; jj < 16; ++jj) {
        const int u = q * 16 + jj; const int tok = dir ? 63 - u : u;
        float hv = Ac[jj] * cin + Bc[jj];
        const size_t trow = (size_t)(start + p0 + tok);
        if (first) hfb[trow * 512 + dir * 256 + chs] = f2bf(hv);
        else zw[trow * ZS + ZC_GC + chs] = f2bf((hv + bfhi(gp[jj])) * silu_f(bflo(gp[jj])));
        if (jj == 15 && q == 3) carry[((tile + 1) & 1) * 64 + c] = hv;
      }
    }
    __syncthreads();
  }
}

DI void phase_mix(const Params& p, int l, char* ldsraw) {
  __shared__ int s_item;
  const int tid = threadIdx.x;
  const int x = blockIdx.x & 7;
  int* ctr = (int*)(p.ws + OFF_CTR) + l * 8 + x;
  bf16_t* z = (bf16_t*)(p.ws + OFF_Z);
  bf16_t* QA = (bf16_t*)(p.ws + OFF_QA);
  bf16_t* KA = (bf16_t*)(p.ws + OFF_KA);
  const bf16_t* VTA = (const bf16_t*)(p.ws + OFF_VTA);
  const bf16_t* VTB = (const bf16_t*)(p.ws + OFF_VTB);
  const bf16_t* VTD = (const bf16_t*)(p.ws + OFF_VTD);
  const float lam = ((const float*)(p.ws + OFF_LAM))[l];
  const float lam_init = l == 0 ? 0.2f : 0.8f - 0.6f * 0.7408182206817179f;
  constexpr int N_ITEMS = 16 + 512 + 256;
  while (true) {
    __syncthreads();
    if (tid == 0) s_item = atomicAdd(ctr, 1);
    __syncthreads();
    int j = __builtin_amdgcn_readfirstlane(s_item);
    if (j >= N_ITEMS) break;
    if (j < 16) { const int id = j * 8 + x; scan_item(p, l, id >> 2, id & 3, ldsraw); continue; }
    j -= 16;
    int type, seq, head, qt;
    if (j < 512) {
      if (j < 256) { type = 1; const int gg = (j >> 5) * 8 + x; seq = gg >> 2; head = gg & 3; qt = j & 31; }
      else { type = j < 384 ? 2 : 0; const int jj = j & 127; const int gg = (jj >> 4) * 8 + x; seq = gg >> 2; head = gg & 3; qt = jj & 15; }
    } else {
      j -= 512;
      if (j < 128) { type = 1; const int gg = (j >> 4) * 8 + x; seq = 16 + (gg >> 2); head = gg & 3; qt = j & 15; }
      else { type = j < 192 ? 2 : 0; const int jj = j & 63; const int gg = (jj >> 3) * 8 + x; seq = 16 + (gg >> 2); head = gg & 3; qt = jj & 7; }
    }
    const int S = seq_len(seq), start = seq_start(seq);
    if (type == 0) {
      attn_item<96, 96, false>(QA + head * 96, 384, KA + head * 96, 384, VTA + (size_t)start * 256 + (size_t)head * 64 * S,
                               z + ZC_VB + head * 64, ZS, z + ZC_GA + head * 64, S, start, qt, (bf16_t*)ldsraw, 0.f, 0.f, nullptr);
    } else if (type == 1) {
      attn_item<32, 64, true>(z + ZC_QB + head * 64, ZS, z + ZC_KB + head * 64, ZS, VTB + (size_t)start * 256 + (size_t)head * 64 * S,
                              z + ZC_QB + head * 64, ZS, z + ZC_GB + head * 64, S, start, qt, (bf16_t*)ldsraw, lam, 1.f - lam_init, p.diff_subln + l * 64);
    } else {
      attn_item<64, 64, false>(z + ZC_QD + head * 64, ZS, z + ZC_KD + (head >> 1) * 64, ZS, VTD + (size_t)start * 128 + (size_t)(head >> 1) * 64 * S,
                               z + ZC_QD + head * 64, ZS, z + ZC_GD + head * 64, S, start, qt, (bf16_t*)ldsraw, 0.f, 0.f, nullptr);
    }
  }
}

DI void phase_outproj(const Params& p, int l, bf16_t* lds) {
  const bf16_t* z = (const bf16_t*)(p.ws + OFF_Z);
  const bf16_t* QA = (const bf16_t*)(p.ws + OFF_QA);
  const bf16_t* hfb = (const bf16_t*)(p.ws + OFF_HFB);
  const bf16_t* wt = (const bf16_t*)(p.ws + OFF_WOUT) + (size_t)l * 1024 * 1024;
  const float* modp = (const float*)(p.ws + OFF_MOD) + (size_t)l * 32 * 3072;
  const int lane = opaque_tid() & 63, r = lane & 31, h = lane >> 5;
  constexpr int NT = 4, MT = T_TOK / 256;
  {
    gemm_stream(z, ZS,
        [&](int kt) {
          const int grp = kt >> 2, sub = kt & 3;
          const int col = grp == 0 ? ZC_VB : (grp == 1 ? ZC_QB : (grp == 2 ? ZC_GC : ZC_QD));
          return col + sub * 64;
        },
        wt, 1024, 16,
        [&](int q, int& tm0, int& tn0) { int mt, nt; const bool v = xcd_tile(q, NT, MT, mt, nt); tm0 = mt * 256; tn0 = nt * 256; return v; },
        [&](int m0, int n64, const f32x16& acc0, const f32x16& acc1) {
         const int lane = opaque_tid() & 63, r = lane & 31, h = lane >> 5;
#pragma unroll
         for (int ni = 0; ni < 2; ++ni) {
          const f32x16& acc = ni == 0 ? acc0 : acc1;
          const int n = n64 + ni * 32 + r;
          int seq, s; tok2seq(m0, seq, s);
          const float gate = modp[seq * 3072 + 2048 + n];
          const float* xb = (l == 0) ? (m0 < T_P ? p.xin0 + (size_t)m0 * 1024 : p.xin1 + (size_t)(m0 - T_P) * 1024) : p.out + (size_t)m0 * 1024;
          xb += (size_t)(4 * h) * 1024 + n;
          float* ob = p.out + (size_t)(m0 + 4 * h) * 1024 + n;
#pragma unroll
          for (int i = 0; i < 16; ++i) {
            const int ro = ((i & 3) + 8 * (i >> 2)) * 1024;
            ob[ro] = xb[ro] + gate * acc[i];
          }
         }
        },
        lds);
  }
}

__global__ void __launch_bounds__(512, 2) hymba_fwd(Params p) {
  cg::grid_group grid = cg::this_grid();
  unsigned* gbar = (unsigned*)(p.ws + OFF_CTR) + 48;
  const unsigned nblk = gridDim.x;
  unsigned gb_n = 0;
  __shared__ __attribute__((aligned(16))) char lds[147456];
  phase0a(p, (float*)lds);
  grid.sync();
  phase_norm(p, 0, 0, true);
  grid_barrier(gbar, nblk * (++gb_n));
#pragma unroll 1
  for (int l = 0; l < 2; ++l) {
    phase_inproj(p, l, (bf16_t*)lds);
    grid_barrier(gbar, nblk * (++gb_n));
    phase_mla_up(p, l, (bf16_t*)lds);
    grid_barrier(gbar, nblk * (++gb_n));
    phase_mix(p, l, lds);
    grid_barrier(gbar, nblk * (++gb_n));
    phase_outproj(p, l, (bf16_t*)lds);
    grid_barrier(gbar, nblk * (++gb_n));
    if (l == 0) { phase_norm(p, 1, 0, false); grid_barrier(gbar, nblk * (++gb_n)); }
    else phase_norm(p, 0, 1, false);
  }
}

extern "C" void kernel_launch(void* const* d_in, const int* in_sizes, int n_in, void* d_out, int out_size, void* d_ws, size_t ws_size, hipStream_t stream) {
  if (ws_size < WS_NEED) { fprintf(stderr, "workspace too small: %zu < %zu\n", ws_size, (size_t)WS_NEED); return; }
  static int grid_blocks = 0;
  if (!grid_blocks) {
    int dev = 0, cus = 0, per_cu = 0;
    hipGetDevice(&dev);
    hipDeviceGetAttribute(&cus, hipDeviceAttributeMultiprocessorCount, dev);
    hipOccupancyMaxActiveBlocksPerMultiprocessor(&per_cu, hymba_fwd, 512, 0);
    if (per_cu > 1) per_cu = 1;
    if (per_cu < 1) per_cu = 1;
    grid_blocks = (cus * per_cu) & ~7;
  }
  Params p{};
  p.xin0 = (const float*)d_in[0]; p.xin1 = (const float*)d_in[1]; p.c0 = (const float*)d_in[2]; p.c1 = (const float*)d_in[3];
  p.ada_w = (const float*)d_in[4]; p.ada_b = (const float*)d_in[5]; p.norm_g = (const float*)d_in[6]; p.w_in = (const float*)d_in[7];
  p.mla_q_norm = (const float*)d_in[8]; p.mla_w_uq = (const float*)d_in[9]; p.mla_kv_norm = (const float*)d_in[10]; p.mla_w_ukv = (const float*)d_in[11];
  p.diff_lambda = (const float*)d_in[12]; p.diff_subln = (const float*)d_in[13]; p.conv_w = (const float*)d_in[14]; p.conv_b = (const float*)d_in[15];
  p.lru_wa = (const float*)d_in[16]; p.lru_ba = (const float*)d_in[17]; p.lru_wx = (const float*)d_in[18]; p.lru_bx = (const float*)d_in[19];
  p.lru_lambda = (const float*)d_in[20]; p.gqa_q_norm = (const float*)d_in[21]; p.gqa_k_norm = (const float*)d_in[22]; p.w_out = (const float*)d_in[23];
  p.final_norm = (const float*)d_in[24];
  p.out = (float*)d_out; p.ws = (char*)d_ws;
  hipMemsetAsync((char*)d_ws + OFF_CTR, 0, 256, stream);
  void* args[] = {&p};
  hipError_t e = hipLaunchCooperativeKernel((void*)hymba_fwd, dim3(grid_blocks), dim3(512), args, 0, stream);
  if (e != hipSuccess) fprintf(stderr, "cooperative launch failed: %s (grid %d)\n", hipGetErrorString(e), grid_blocks);
}
```

```cpp
#include <hip/hip_runtime.h>
#include <hip/hip_cooperative_groups.h>
#include <cstdio>
#include <cstdint>
namespace cg = cooperative_groups;

typedef unsigned short bf16_t;
using bf16x8 = __attribute__((ext_vector_type(8))) short;
using f32x16 = __attribute__((ext_vector_type(16))) float;
typedef __bf16 bf16x2_t __attribute__((ext_vector_type(2)));
typedef float f32x2_t __attribute__((ext_vector_type(2)));
using u32x4 = __attribute__((ext_vector_type(4))) unsigned;
using u32x2 = __attribute__((ext_vector_type(2))) unsigned;
#define DI __device__ __forceinline__
#define MFMA(a, b, c) __builtin_amdgcn_mfma_f32_32x32x16_bf16((a), (b), (c), 0, 0, 0)

constexpr int T_TOK = 98304, T_P = 65536, DM = 1024, ZS = 2944, NIN = 2912;
constexpr int ZC_QB = 0, ZC_KB = 256, ZC_VB = 512, ZC_GB = 768, ZC_XC = 1024, ZC_GC = 1280, ZC_QD = 1536,
              ZC_KD = 1792, ZC_VD = 1920, ZC_GD = 2048, ZC_GA = 2304, ZC_QA = 2560, ZC_KVA = 2752, ZC_KRA = 2880;
constexpr float LOG2E = 1.4426950408889634f;
constexpr float EPSN = 1e-6f;

constexpr size_t OFF_H = 0;
constexpr size_t SZ_H = (size_t)T_TOK * 1024 * 2;
constexpr size_t OFF_QA = OFF_H;
constexpr size_t OFF_KA = OFF_H + (size_t)T_TOK * 384 * 2;
constexpr size_t OFF_VTA = OFF_H + (size_t)T_TOK * 768 * 2;
constexpr size_t OFF_Z = OFF_H + SZ_H;
constexpr size_t OFF_VTB = OFF_Z + (size_t)T_TOK * ZS * 2;
constexpr size_t OFF_VTD = OFF_VTB + (size_t)T_TOK * 256 * 2;
constexpr size_t OFF_HFB = OFF_VTD + (size_t)T_TOK * 128 * 2;
constexpr size_t OFF_WIN = OFF_HFB + (size_t)T_TOK * 512 * 2;
constexpr size_t OFF_WOUT = OFF_WIN + (size_t)2 * 3072 * 1024 * 2;
constexpr size_t OFF_WUQ = OFF_WOUT + (size_t)2 * 1024 * 1280 * 2;
constexpr size_t OFF_WUKV = OFF_WUQ + (size_t)2 * 512 * 192 * 2;
constexpr size_t OFF_WLRU = OFF_WUKV + (size_t)2 * 512 * 128 * 2;
constexpr size_t OFF_MOD = OFF_WLRU + (size_t)2 * 2 * 2 * 4 * 64 * 64 * 2;
constexpr size_t OFF_TABM = OFF_MOD + (size_t)2 * 32 * 3072 * 4;
constexpr size_t OFF_TABP = OFF_TABM + (size_t)4096 * 16 * 8;
constexpr size_t OFF_TABX = OFF_TABP + (size_t)4096 * 4 * 8;
constexpr size_t OFF_LAM = OFF_TABX + (size_t)64 * 16 * 8;
constexpr size_t OFF_CTR = OFF_LAM + 256;
constexpr size_t OFF_RSS = OFF_CTR + 256;
constexpr size_t WS_NEED = OFF_RSS + (size_t)T_TOK * 8 * 4;

struct Params {
  const float* xin0; const float* xin1; const float* c0; const float* c1;
  const float *ada_w, *ada_b, *norm_g, *w_in, *mla_q_norm, *mla_w_uq, *mla_kv_norm, *mla_w_ukv,
      *diff_lambda, *diff_subln, *conv_w, *conv_b, *lru_wa, *lru_ba, *lru_wx, *lru_bx, *lru_lambda,
      *gqa_q_norm, *gqa_k_norm, *w_out, *final_norm;
  float* out;
  char* ws;
};

DI unsigned pack2(float a, float b) { f32x2_t v = {a, b}; bf16x2_t o = __builtin_convertvector(v, bf16x2_t); return __builtin_bit_cast(unsigned, o); }
DI bf16_t f2bf(float a) { return (bf16_t)(pack2(a, 0.f) & 0xffffu); }
DI float bf2f(bf16_t v) { return __uint_as_float(((unsigned)v) << 16); }
DI float bflo(unsigned u) { return __uint_as_float(u << 16); }
DI float bfhi(unsigned u) { return __uint_as_float(u & 0xffff0000u); }
DI int opaque_tid() { int t = threadIdx.x; asm volatile("" : "+v"(t)); return t; }
DI int crow(int i, int h) { return (i & 3) + 8 * (i >> 2) + 4 * h; }
DI int seq_start(int seq) { return seq < 16 ? (seq << 12) : T_P + ((seq - 16) << 11); }
DI int seq_len(int seq) { return seq < 16 ? 4096 : 2048; }
DI void tok2seq(int t, int& seq, int& s) { if (t < T_P) { seq = t >> 12; s = t & 4095; } else { int u = t - T_P; seq = 16 + (u >> 11); s = u & 2047; } }
DI float silu_f(float x) { return x / (1.f + __expf(-x)); }
DI float sigmoid_f(float x) { return 1.f / (1.f + __expf(-x)); }
DI float xhalf_max(float v) { unsigned u = __float_as_uint(v); auto rr = __builtin_amdgcn_permlane32_swap(u, u, false, false); return fmaxf(__uint_as_float(rr[0]), __uint_as_float(rr[1])); }
DI float xhalf_sum(float v) { unsigned u = __float_as_uint(v); auto rr = __builtin_amdgcn_permlane32_swap(u, u, false, false); return __uint_as_float(rr[0]) + __uint_as_float(rr[1]); }
DI void grid_barrier(unsigned* ctr, unsigned target) {
  __syncthreads();
  if (threadIdx.x == 0) {
    __threadfence();
    atomicAdd(ctr, 1u);
    while (__hip_atomic_load(ctr, __ATOMIC_RELAXED, __HIP_MEMORY_SCOPE_AGENT) < target) __builtin_amdgcn_s_sleep(4);
    __threadfence();
  }
  __syncthreads();
}
DI float wave_sum(float v) {
  v += __shfl_xor(v, 32); v += __shfl_xor(v, 16); v += __shfl_xor(v, 8); v += __shfl_xor(v, 4); v += __shfl_xor(v, 2); v += __shfl_xor(v, 1);
  return v;
}

constexpr int G_LDP = 72;
constexpr int G_STAGE = 512 * G_LDP;
template <class ASrc, class Epi>
DI void gemm_tile(ASrc asrc, const bf16_t* __restrict__ Bt, int ldb, int nk, int m0, int n0, Epi epi, bf16_t* lds) {
  const int tid = opaque_tid(), lane = tid & 63, w = tid >> 6, r = lane & 31, h = lane >> 5;
  const int wm = w >> 2, wn = w & 3;
  f32x16 acc[4][2];
#pragma unroll
  for (int mi = 0; mi < 4; ++mi)
#pragma unroll
    for (int ni = 0; ni < 2; ++ni)
#pragma unroll
      for (int i = 0; i < 16; ++i) acc[mi][ni][i] = 0.f;
  u32x4 ra[4], rb[4];
  const int lrow = tid >> 3, lch = tid & 7;
  auto gload = [&](int kt) {
    const bf16_t* ab; int as; asrc(kt, ab, as);
#pragma unroll
    for (int i = 0; i < 4; ++i) ra[i] = *(const u32x4*)(ab + (size_t)(m0 + lrow + 64 * i) * as + lch * 8);
#pragma unroll
    for (int i = 0; i < 4; ++i) rb[i] = *(const u32x4*)(Bt + (size_t)(n0 + lrow + 64 * i) * ldb + kt * 64 + lch * 8);
  };
  auto lstore = [&](int buf) {
    bf16_t* As = lds + buf * G_STAGE; bf16_t* Bs = As + 256 * G_LDP;
#pragma unroll
    for (int i = 0; i < 4; ++i) *(u32x4*)(As + (lrow + 64 * i) * G_LDP + lch * 8) = ra[i];
#pragma unroll
    for (int i = 0; i < 4; ++i) *(u32x4*)(Bs + (lrow + 64 * i) * G_LDP + lch * 8) = rb[i];
  };
  __syncthreads();
  gload(0);
  lstore(0);
  gload(1);
  for (int t = 0; t < nk; ++t) {
    __syncthreads();
    if (t + 1 < nk) lstore((t + 1) & 1);
    if (t + 2 < nk) gload(t + 2);
    const bf16_t* As = lds + (t & 1) * G_STAGE; const bf16_t* Bs = As + 256 * G_LDP;
#pragma unroll
    for (int ks = 0; ks < 4; ++ks) {
      bf16x8 a[4], b[2];
#pragma unroll
      for (int mi = 0; mi < 4; ++mi) a[mi] = *(const bf16x8*)(As + (wm * 128 + mi * 32 + r) * G_LDP + ks * 16 + 8 * h);
#pragma unroll
      for (int ni = 0; ni < 2; ++ni) b[ni] = *(const bf16x8*)(Bs + (wn * 64 + ni * 32 + r) * G_LDP + ks * 16 + 8 * h);
#pragma unroll
      for (int mi = 0; mi < 4; ++mi)
#pragma unroll
        for (int ni = 0; ni < 2; ++ni) acc[mi][ni] = MFMA(a[mi], b[ni], acc[mi][ni]);
    }
  }
#pragma unroll
  for (int mi = 0; mi < 4; ++mi)
#pragma unroll
    for (int ni = 0; ni < 2; ++ni) epi(m0 + wm * 128 + mi * 32, n0 + wn * 64 + ni * 32, acc[mi][ni]);
}

template <class ACol, class TileFn, class Epi>
DI void gemm_stream(const bf16_t* __restrict__ Abase, int as, ACol acol, const bf16_t* __restrict__ Bt, int ldb, int nk, TileFn tile_fn, Epi epi, bf16_t* lds) {
  const int tid = opaque_tid(), lane = tid & 63, w = tid >> 6, r = lane & 31, h = lane >> 5;
  const int wm = w >> 2, wn = w & 3;
  u32x4 ra[4], rb[4];
  const int lrow = tid >> 3, lch = tid & 7;
  const bf16_t* ap; const bf16_t* bp;
  auto gload = [&](int kt) {
    const int ac = acol(kt);
#pragma unroll
    for (int i = 0; i < 4; ++i) ra[i] = *(const u32x4*)(ap + (size_t)(64 * i) * as + ac);
#pragma unroll
    for (int i = 0; i < 4; ++i) rb[i] = *(const u32x4*)(bp + (size_t)(64 * i) * ldb + kt * 64);
  };
  auto lstore = [&](int buf) {
    bf16_t* As = lds + buf * G_STAGE; bf16_t* Bs = As + 256 * G_LDP;
#pragma unroll
    for (int i = 0; i < 4; ++i) *(u32x4*)(As + (lrow + 64 * i) * G_LDP + lch * 8) = ra[i];
#pragma unroll
    for (int i = 0; i < 4; ++i) *(u32x4*)(Bs + (lrow + 64 * i) * G_LDP + lch * 8) = rb[i];
  };
  int q = blockIdx.x >> 3; const int qstep = gridDim.x >> 3;
  int m0, n0;
  if (!tile_fn(q, m0, n0)) return;
  ap = Abase + (size_t)(m0 + lrow) * as + lch * 8; bp = Bt + (size_t)(n0 + lrow) * ldb + lch * 8;
  gload(0);
  while (true) {
    f32x16 acc[4][2];
#pragma unroll
    for (int mi = 0; mi < 4; ++mi)
#pragma unroll
      for (int ni = 0; ni < 2; ++ni)
#pragma unroll
        for (int i = 0; i < 16; ++i) acc[mi][ni][i] = 0.f;
    __syncthreads();
    lstore(0);
    gload(1);
    for (int t = 0; t < nk; ++t) {
      __syncthreads();
      const bf16_t* As = lds + (t & 1) * G_STAGE; const bf16_t* Bs = As + 256 * G_LDP;
      bf16_t* Asn = lds + ((t + 1) & 1) * G_STAGE; bf16_t* Bsn = Asn + 256 * G_LDP;
      const int ac2 = (t + 2 < nk) ? acol(t + 2) : 0;
#pragma unroll
      for (int ks = 0; ks < 4; ++ks) {
        bf16x8 a[4], b[2];
#pragma unroll
        for (int mi = 0; mi < 4; ++mi) a[mi] = *(const bf16x8*)(As + (wm * 128 + mi * 32 + r) * G_LDP + ks * 16 + 8 * h);
#pragma unroll
        for (int ni = 0; ni < 2; ++ni) b[ni] = *(const bf16x8*)(Bs + (wn * 64 + ni * 32 + r) * G_LDP + ks * 16 + 8 * h);
#pragma unroll
        for (int mi = 0; mi < 4; ++mi)
#pragma unroll
          for (int ni = 0; ni < 2; ++ni) acc[mi][ni] = MFMA(a[mi], b[ni], acc[mi][ni]);
        if (t + 1 < nk) {
          *(u32x4*)(Asn + (lrow + 64 * ks) * G_LDP + lch * 8) = ra[ks];
          *(u32x4*)(Bsn + (lrow + 64 * ks) * G_LDP + lch * 8) = rb[ks];
        }
        if (t + 2 < nk) {
          ra[ks] = *(const u32x4*)(ap + (size_t)(64 * ks) * as + ac2);
          rb[ks] = *(const u32x4*)(bp + (size_t)(64 * ks) * ldb + (t + 2) * 64);
        }
      }
    }
    q += qstep;
    int m1, n1;
    const bool v1 = tile_fn(q, m1, n1);
    if (v1) { ap = Abase + (size_t)(m1 + lrow) * as + lch * 8; bp = Bt + (size_t)(n1 + lrow) * ldb + lch * 8; gload(0); }
#pragma unroll
    for (int mi = 0; mi < 4; ++mi) epi(m0 + wm * 128 + mi * 32, n0 + wn * 64, acc[mi][0], acc[mi][1]);
    if (!v1) break;
    m0 = m1; n0 = n1;
  }
}

DI bool xcd_tile(int q, int n_sub, int n_mt, int& mt, int& sub) {
  const int x = blockIdx.x & 7;
  const int mloc = q / n_sub; sub = q - mloc * n_sub;
  mt = mloc * 8 + x;
  return mt < n_mt;
}

template <class SrcFn>
DI void transpose64(SrcFn src, bf16_t* dst, int dld, int k0, int n0, float* tile) {
  const int tid = opaque_tid();
  __syncthreads();
  {
    const int nn = tid & 63, kq = tid >> 6;
#pragma unroll 4
    for (int i = 0; i < 8; ++i) { int kk = kq + 8 * i; tile[kk * 65 + nn] = src(k0 + kk, n0 + nn); }
  }
  __syncthreads();
  {
    const int kk2 = (tid & 31) * 2, nq = tid >> 5;
#pragma unroll 4
    for (int i = 0; i < 4; ++i) {
      int nn2 = nq + 16 * i;
      *(unsigned*)(dst + (size_t)(n0 + nn2) * dld + k0 + kk2) = pack2(tile[kk2 * 65 + nn2], tile[(kk2 + 1) * 65 + nn2]);
    }
  }
}

DI int win_perm(int n) {
  if (n < 2304) return n + 608;
  if (n < 2560) return n - 2304 + 352;
  if (n < 2752) return n - 2560;
  if (n < 2880) return n - 2752 + 192;
  if (n < 2912) return n - 2880 + 320;
  return -1;
}

DI void mod_item(const Params& p, int l, int nc, float* lds) {
  float* sc = lds;
  float* red = lds + 8192;
  const int tid = opaque_tid(), col = tid & 63, kq = tid >> 6;
  const int n = nc * 64 + col;
  float acc[32];
#pragma unroll
  for (int i = 0; i < 32; ++i) acc[i] = 0.f;
  const float* W = p.ada_w + (size_t)l * 1024 * 3072;
  for (int st = 0; st < 4; ++st) {
    __syncthreads();
    for (int e = 0; e < 16; ++e) {
      int idx = e * 512 + tid; int seq = idx >> 8, kk = idx & 255;
      const float* cp = seq < 16 ? p.c0 + seq * 1024 : p.c1 + (seq - 16) * 1024;
      sc[kk * 32 + seq] = silu_f(cp[st * 256 + kk]);
    }
    __syncthreads();
    for (int kk0 = 0; kk0 < 32; kk0 += 8) {
      float wv[8];
#pragma unroll
      for (int u = 0; u < 8; ++u) wv[u] = W[(size_t)(st * 256 + kq * 32 + kk0 + u) * 3072 + n];
#pragma unroll
      for (int u = 0; u < 8; ++u) {
        const float4* s4 = (const float4*)(sc + (kq * 32 + kk0 + u) * 32);
#pragma unroll
        for (int j = 0; j < 8; ++j) { float4 v = s4[j]; acc[4 * j] += v.x * wv[u]; acc[4 * j + 1] += v.y * wv[u]; acc[4 * j + 2] += v.z * wv[u]; acc[4 * j + 3] += v.w * wv[u]; }
      }
    }
  }
  __syncthreads();
#pragma unroll
  for (int i = 0; i < 32; ++i) red[(kq * 32 + i) * 64 + col] = acc[i];
  __syncthreads();
  float* modp = (float*)(p.ws + OFF_MOD) + (size_t)l * 32 * 3072;
  for (int e = 0; e < 4; ++e) {
    int seq = kq * 4 + e;
    float v = 0.f;
#pragma unroll
    for (int g = 0; g < 8; ++g) v += red[(g * 32 + seq) * 64 + col];
    modp[seq * 3072 + n] = v + p.ada_b[l * 3072 + n];
  }
  __syncthreads();
}

DI void phase0a(const Params& p, float* lds) {
  const int tid = opaque_tid();
  bf16_t* wt_in = (bf16_t*)(p.ws + OFF_WIN);
  bf16_t* wt_out = (bf16_t*)(p.ws + OFF_WOUT);
  bf16_t* wt_uq = (bf16_t*)(p.ws + OFF_WUQ);
  bf16_t* wt_ukv = (bf16_t*)(p.ws + OFF_WUKV);
  bf16_t* wlru = (bf16_t*)(p.ws + OFF_WLRU);
  constexpr int N_MOD = 96, N_WIN = 2 * 48 * 16, N_WOUT = 2 * 16 * 16, N_WUQ = 2 * 8 * 3, N_WUKV = 2 * 8 * 2, N_LRU = 32, N_TAB = 162;
  constexpr int N_ALL = N_MOD + N_WIN + N_WOUT + N_WUQ + N_WUKV + N_LRU + N_TAB + 1;
  for (int it = blockIdx.x; it < N_ALL; it += gridDim.x) {
    int j = it;
    if (j < N_MOD) { mod_item(p, j / 48, j % 48, lds); continue; }
    j -= N_MOD;
    if (j < N_WIN) {
      int l = j / (48 * 16), rem = j % (48 * 16), nt = rem / 16, kt = rem % 16;
      const float* src = p.w_in + (size_t)l * 1024 * NIN;
      transpose64([&](int k, int n) { int on = win_perm(n); return on >= 0 ? src[(size_t)k * NIN + on] : 0.f; },
                  wt_in + (size_t)l * 3072 * 1024, 1024, kt * 64, nt * 64, lds);
      continue;
    }
    j -= N_WIN;
    if (j < N_WOUT) {
      int l = j / (16 * 16), rem = j % (16 * 16), nt = rem / 16, kt = rem % 16;
      const float* src = p.w_out + (size_t)l * 1024 * 1024;
      transpose64([&](int k, int n) { return src[(size_t)k * 1024 + n]; },
                  wt_out + (size_t)l * 1024 * 1024, 1024, kt * 64, nt * 64, lds);
      continue;
    }
    j -= N_WOUT;
    if (j < N_WUQ) {
      int l = j / 24, rem = j % 24, nt = rem / 3, kt = rem % 3;
      const float* src = p.mla_w_uq + (size_t)l * 192 * 384;
      const float* gq = p.mla_q_norm + l * 192;
      transpose64([&](int k, int n) { return n < 384 ? src[(size_t)k * 384 + n] * gq[k] : 0.f; }, wt_uq + (size_t)l * 512 * 192, 192, kt * 64, nt * 64, lds);
      continue;
    }
    j -= N_WUQ;
    if (j < N_WUKV) {
      int l = j / 16, rem = j % 16, nt = rem / 2, kt = rem % 2;
      const float* src = p.mla_w_ukv + (size_t)l * 128 * 512;
      const float* gk = p.mla_kv_norm + l * 128;
      transpose64([&](int k, int n) { return src[(size_t)k * 512 + n] * gk[k]; }, wt_ukv + (size_t)l * 512 * 128, 128, kt * 64, nt * 64, lds);
      continue;
    }
    j -= N_WUKV;
    if (j < N_LRU) {
      int hh = j & 3, mat = (j >> 2) & 1, d = (j >> 3) & 1, l = j >> 4;
      const float* src = (mat ? p.lru_wx : p.lru_wa) + (size_t)((l * 2 + d) * 4 + hh) * 4096;
      transpose64([&](int k, int n) { return src[k * 64 + n]; }, wlru + (size_t)j * 4096, 64, 0, 0, lds);
      continue;
    }
    j -= N_LRU;
    if (j < N_TAB) {
      int e = j * 512 + tid;
      float2* tm = (float2*)(p.ws + OFF_TABM); float2* tp = (float2*)(p.ws + OFF_TABP); float2* tx = (float2*)(p.ws + OFF_TABX);
      if (e < 65536) { int pos = e >> 4, f = e & 15; float inv = powf(10000.f, -(float)f / 16.f); float a = (float)pos * inv; tm[e] = make_float2(cosf(a), sinf(a)); }
      else if (e < 65536 + 16384) { int q = e - 65536; int pos = q >> 2, f = q & 3; float inv = powf(500000.f, -(float)f / 4.f); float a = (float)pos * inv; tp[q] = make_float2(cosf(a), sinf(a)); }
      else if (e < 65536 + 16384 + 1024) { int q = e - 65536 - 16384; int pos = q >> 4, f = q & 15; float inv = powf(10000.f, -(float)f / 16.f); float a = (float)pos * inv; tx[q] = make_float2(cosf(a), sinf(a)); }
      continue;
    }
    if (tid < 2) {
      int l = tid; const float* lf = p.diff_lambda + l * 128;
      float s1 = 0.f, s2 = 0.f;
      for (int i = 0; i < 32; ++i) { s1 += lf[i] * lf[32 + i]; s2 += lf[64 + i] * lf[96 + i]; }
      float lam_init = 0.8f - 0.6f * expf(-0.3f * (float)l);
      ((float*)(p.ws + OFF_LAM))[l] = expf(s1) - expf(s2) + lam_init;
    }
  }
}

DI void phase_norm(const Params& p, int l, int mode, bool from_input) {
  using f32x4 = __attribute__((ext_vector_type(4))) float;
  const int tid = opaque_tid(), lane = tid & 63, w = tid >> 6;
  bf16_t* hbuf = (bf16_t*)(p.ws + OFF_H);
  const float* modp = (const float*)(p.ws + OFF_MOD) + (size_t)l * 32 * 3072;
  const float* g = mode == 0 ? p.norm_g + l * 1024 : p.final_norm;
  for (int it = blockIdx.x; it < T_TOK / 32; it += gridDim.x) {
    const int t0 = it * 32 + w * 4;
    const float* xr0 = from_input ? (t0 < T_P ? p.xin0 + (size_t)t0 * 1024 : p.xin1 + (size_t)(t0 - T_P) * 1024) : p.out + (size_t)t0 * 1024;
    f32x4 v[4][4];
#pragma unroll
    for (int rr = 0; rr < 4; ++rr)
#pragma unroll
      for (int j = 0; j < 4; ++j) v[rr][j] = *(const f32x4*)(xr0 + rr * 1024 + j * 256 + lane * 4);
    f32x4 gs[4], sh4[4];
    {
      int seq, s; tok2seq(t0, seq, s);
      const float* sh = modp + seq * 3072; const float* scl = sh + 1024;
#pragma unroll
      for (int j = 0; j < 4; ++j) {
        const int k = j * 256 + lane * 4;
        f32x4 gg = *(const f32x4*)(g + k);
        if (mode == 0) { f32x4 s4 = *(const f32x4*)(scl + k); gs[j] = gg * (1.f + s4); sh4[j] = *(const f32x4*)(sh + k); }
        else { gs[j] = gg; sh4[j] = gg * 0.f; }
      }
    }
#pragma unroll
    for (int rr = 0; rr < 4; ++rr) {
      float ss = 0.f;
#pragma unroll
      for (int j = 0; j < 4; ++j) ss += v[rr][j].x * v[rr][j].x + v[rr][j].y * v[rr][j].y + v[rr][j].z * v[rr][j].z + v[rr][j].w * v[rr][j].w;
      ss = wave_sum(ss);
      const float rstd = rsqrtf(ss * (1.f / 1024.f) + EPSN);
      const int t = t0 + rr;
#pragma unroll
      for (int j = 0; j < 4; ++j) {
        const int k = j * 256 + lane * 4;
        f32x4 o = v[rr][j] * rstd * gs[j] + sh4[j];
        if (mode == 0) {
          u32x2 ou = {pack2(o.x, o.y), pack2(o.z, o.w)};
          *(u32x2*)(hbuf + (size_t)t * 1024 + k) = ou;
        } else {
          *(f32x4*)(p.out + (size_t)t * 1024 + k) = o;
        }
      }
    }
  }
}

DI void phase_inproj(const Params& p, int l, bf16_t* lds) {
  const bf16_t* hbuf = (const bf16_t*)(p.ws + OFF_H);
  const bf16_t* wt = (const bf16_t*)(p.ws + OFF_WIN) + (size_t)l * 3072 * 1024;
  bf16_t* z = (bf16_t*)(p.ws + OFF_Z);
  bf16_t* vtb = (bf16_t*)(p.ws + OFF_VTB);
  bf16_t* vtd = (bf16_t*)(p.ws + OFF_VTD);
  float* rss = (float*)(p.ws + OFF_RSS);
  const float2* tm = (const float2*)(p.ws + OFF_TABM); const float2* tp = (const float2*)(p.ws + OFF_TABP); const float2* tx = (const float2*)(p.ws + OFF_TABX);
  const float SCB = 0.17677669529663687f * LOG2E;
  const float SCD = 0.125f * LOG2E;
  constexpr int NT = 12, MT = T_TOK / 256;
  {
    gemm_stream(hbuf, 1024, [&](int kt) { return kt * 64; }, wt, 1024, 16,
              [&](int q, int& tm0, int& tn0) { int mt, nt; const bool v = xcd_tile(q, NT, MT, mt, nt); nt = (nt + (mt >> 3)) % NT; tm0 = mt * 256; tn0 = nt * 256; return v; },
              [&](int m0, int n64, const f32x16& acc0, const f32x16& acc1) {
                const int lane = opaque_tid() & 63, r = lane & 31, h = lane >> 5;
                int seq, s0; tok2seq(m0, seq, s0);
                const int S = seq_len(seq), st = seq_start(seq);
                if (n64 >= ZC_QD && n64 < ZC_VD) {
                  const bool isq = n64 < ZC_KD;
                  const float* gn = (isq ? p.gqa_q_norm : p.gqa_k_norm) + l * 64;
                  const float g0 = gn[r], g1 = gn[32 + r];
                  const float scl = isq ? SCD : 1.f;
#pragma unroll
                  for (int i = 0; i < 16; ++i) {
                    float ss = acc0[i] * acc0[i] + acc1[i] * acc1[i];
                    ss += __shfl_xor(ss, 1); ss += __shfl_xor(ss, 2); ss += __shfl_xor(ss, 4); ss += __shfl_xor(ss, 8); ss += __shfl_xor(ss, 16);
                    const float rstd = rsqrtf(ss * (1.f / 64.f) + EPSN);
                    const int sp = s0 + crow(i, h);
                    const float x0 = acc0[i] * rstd * g0, x1 = acc1[i] * rstd * g1;
                    const float p0 = __shfl_xor(x0, 16), p1 = __shfl_xor(x1, 16);
                    const float2 c0 = tx[(sp >> 6) * 16 + (r & 15)], c1 = tx[(sp & 63) * 16 + (r & 15)];
                    const float o0 = (r < 16 ? x0 * c0.x - p0 * c0.y : x0 * c0.x + p0 * c0.y) * scl;
                    const float o1 = (r < 16 ? x1 * c1.x - p1 * c1.y : x1 * c1.x + p1 * c1.y) * scl;
                    bf16_t* zr = z + (size_t)(m0 + crow(i, h)) * ZS + n64 + r;
                    zr[0] = f2bf(o0); zr[32] = f2bf(o1);
                  }
                  return;
                }
                if (n64 >= ZC_QA && n64 < ZC_KRA) {
                  float* rs = rss + (size_t)(m0 + 4 * h) * 8 + ((n64 - ZC_QA) >> 6);
#pragma unroll
                  for (int i = 0; i < 16; ++i) {
                    float ss = acc0[i] * acc0[i] + acc1[i] * acc1[i];
                    ss += __shfl_xor(ss, 1); ss += __shfl_xor(ss, 2); ss += __shfl_xor(ss, 4); ss += __shfl_xor(ss, 8); ss += __shfl_xor(ss, 16);
                    if (r == 0) rs[((i & 3) + 8 * (i >> 2)) * 8] = ss;
                  }
                }
#pragma unroll
                for (int ni = 0; ni < 2; ++ni) {
                  const f32x16& acc = ni == 0 ? acc0 : acc1;
                  const int n0 = n64 + ni * 32;
                  const int n = n0 + r;
                  if (n0 >= ZC_VB && n0 < ZC_GB) {
                    bf16_t* base = vtb + (size_t)st * 256 + (size_t)(n - ZC_VB) * S + s0;
#pragma unroll
                    for (int g4 = 0; g4 < 4; ++g4)
                      *(uint2*)(base + 8 * g4 + 4 * h) = make_uint2(pack2(acc[4 * g4], acc[4 * g4 + 1]), pack2(acc[4 * g4 + 2], acc[4 * g4 + 3]));
                  } else if (n0 >= ZC_VD && n0 < ZC_GD) {
                    bf16_t* base = vtd + (size_t)st * 128 + (size_t)(n - ZC_VD) * S + s0;
#pragma unroll
                    for (int g4 = 0; g4 < 4; ++g4)
                      *(uint2*)(base + 8 * g4 + 4 * h) = make_uint2(pack2(acc[4 * g4], acc[4 * g4 + 1]), pack2(acc[4 * g4 + 2], acc[4 * g4 + 3]));
                  } else if (n0 < ZC_VB) {
                    const float scl = n0 < ZC_KB ? SCB : 1.f;
#pragma unroll
                    for (int i = 0; i < 16; ++i) {
                      const float x = acc[i];
                      const float pr = __shfl_xor(x, 4);
                      const float2 cs = tp[(s0 + crow(i, h)) * 4 + (r & 3)];
                      const float o = r < 4 ? x * cs.x - pr * cs.y : (r < 8 ? x * cs.x + pr * cs.y : x);
                      z[(size_t)(m0 + crow(i, h)) * ZS + n] = f2bf(o * scl);
                    }
                  } else if (n0 == ZC_KRA) {
#pragma unroll
                    for (int i = 0; i < 16; ++i) {
                      const float x = acc[i];
                      const float pr = __shfl_xor(x, 16);
                      const float2 cs = tm[(s0 + crow(i, h)) * 16 + (r & 15)];
                      z[(size_t)(m0 + crow(i, h)) * ZS + n] = f2bf(r < 16 ? x * cs.x - pr * cs.y : x * cs.x + pr * cs.y);
                    }
                  } else if (n0 < NIN) {
#pragma unroll
                    for (int i = 0; i < 16; ++i) z[(size_t)(m0 + crow(i, h)) * ZS + n] = f2bf(acc[i]);
                  }
                }
              },
              lds);
  }
}

DI void phase_mla_up(const Params& p, int l, bf16_t* lds) {
  const bf16_t* z = (const bf16_t*)(p.ws + OFF_Z);
  bf16_t* QA = (bf16_t*)(p.ws + OFF_QA);
  bf16_t* KA = (bf16_t*)(p.ws + OFF_KA);
  bf16_t* VTA = (bf16_t*)(p.ws + OFF_VTA);
  const bf16_t* wuq = (const bf16_t*)(p.ws + OFF_WUQ) + (size_t)l * 512 * 192;
  const bf16_t* wukv = (const bf16_t*)(p.ws + OFF_WUKV) + (size_t)l * 512 * 128;
  const float2* tm = (const float2*)(p.ws + OFF_TABM);
  const float* rss = (const float*)(p.ws + OFF_RSS);
  const int lane = opaque_tid() & 63, r = lane & 31, h = lane >> 5;
  const float SCA = 0.10206207261596577f * LOG2E;
  constexpr int MT = T_TOK / 256;
  for (int q = blockIdx.x >> 3;; q += gridDim.x >> 3) {
    int mt, sub;
    if (!xcd_tile(q, 4, MT, mt, sub)) break;
    sub = (sub + (mt >> 6)) & 3;
    if (sub < 2) {
      gemm_tile([&](int kt, const bf16_t*& ab, int& as) { ab = z + ZC_QA + kt * 64; as = ZS; }, wuq, 192, 3, mt * 256, sub * 256,
                [&](int m0, int n0, const f32x16& acc) {
                  if (n0 >= 384) return;
                  const int n = n0 + r;
                  const bool pe = ((n0 >> 5) % 3) == 2;
                  int seq, s0; tok2seq(m0, seq, s0);
#pragma unroll
                  for (int i = 0; i < 16; ++i) {
                    const float* rs = rss + (size_t)(m0 + crow(i, h)) * 8;
                    float x = acc[i] * rsqrtf((rs[0] + rs[1] + rs[2]) * (1.f / 192.f) + EPSN);
                    if (pe) {
                      float pr = __shfl_xor(x, 16);
                      float2 cs = tm[(s0 + crow(i, h)) * 16 + (r & 15)];
                      x = (r < 16) ? x * cs.x - pr * cs.y : x * cs.x + pr * cs.y;
                    }
                    QA[(size_t)(m0 + crow(i, h)) * 384 + n] = f2bf(x * SCA);
                  }
                },
                lds);
    } else {
      gemm_tile([&](int kt, const bf16_t*& ab, int& as) { ab = z + ZC_KVA + kt * 64; as = ZS; }, wukv, 128, 2, mt * 256, (sub - 2) * 256,
                [&](int m0, int n0, const f32x16& acc) {
                  const int hh = n0 >> 7;
                  const int nn = (n0 & 127) + r;
                  auto rstd_of = [&](int i) { const float* rs = rss + (size_t)(m0 + crow(i, h)) * 8; return rsqrtf((rs[3] + rs[4]) * (1.f / 128.f) + EPSN); };
                  if (nn < 64) {
#pragma unroll
                    for (int i = 0; i < 16; ++i) KA[(size_t)(m0 + crow(i, h)) * 384 + hh * 96 + nn] = f2bf(acc[i] * rstd_of(i));
                    if (nn >= 32) {
#pragma unroll
                      for (int i = 0; i < 16; ++i) KA[(size_t)(m0 + crow(i, h)) * 384 + hh * 96 + 64 + r] = z[(size_t)(m0 + crow(i, h)) * ZS + ZC_KRA + r];
                    }
                  } else {
                    int seq, s; tok2seq(m0, seq, s); const int S = seq_len(seq), st = seq_start(seq);
                    bf16_t* base = VTA + (size_t)st * 256 + (size_t)(hh * 64 + nn - 64) * S + s;
#pragma unroll
                    for (int g4 = 0; g4 < 4; ++g4)
                      *(uint2*)(base + 8 * g4 + 4 * h) = make_uint2(pack2(acc[4 * g4] * rstd_of(4 * g4), acc[4 * g4 + 1] * rstd_of(4 * g4 + 1)), pack2(acc[4 * g4 + 2] * rstd_of(4 * g4 + 2), acc[4 * g4 + 3] * rstd_of(4 * g4 + 3)));
                  }
                },
                lds);
    }
  }
}

template <int DK, int KW, bool DIFF>
DI void attn_item(const bf16_t* qp, int qstride, const bf16_t* kp, int kstride, const bf16_t* vt, bf16_t* op, int ostride, const bf16_t* gp,
                  int S, int start, int qt, bf16_t* lds, float lam, float post_scale, const float* subln) {
  constexpr int KWP = KW + 8;
  constexpr int KCH = KW / 8;
  constexpr int KLD = (64 * KCH + 511) / 512;
  constexpr int NKS = DK / 16;
  bf16_t* Ks = lds;
  bf16_t* Vs = lds + 2 * 64 * KWP;
  float* Xc = (float*)(lds + 2 * 64 * KWP + 2 * 64 * 72);
  const int tid = opaque_tid(), lane = tid & 63, w = tid >> 6, r = lane & 31, h = lane >> 5;
  const int sub = DIFF ? (w >> 2) : 0;
  const int rblk = DIFF ? (w & 3) : w;
  const int koff = DIFF ? sub * DK : 0;
  const int qrow = start + qt * (DIFF ? 128 : 256) + rblk * 32 + r;
  bf16x8 qf[NKS];
#pragma unroll
  for (int ks = 0; ks < NKS; ++ks) qf[ks] = *(const bf16x8*)(qp + (size_t)qrow * qstride + koff + ks * 16 + 8 * h);
  constexpr bool USE_NM = true;
  f32x16 O[2], NM;
  float lrun = 0.f, mref = 0.f;
#pragma unroll
  for (int e = 0; e < 16; ++e) { O[0][e] = 0.f; O[1][e] = 0.f; NM[e] = 0.f; }
  u32x4 kreg[KLD], vreg;
  const int vrow = tid >> 3, vch = tid & 7;
  const int nt = S / 64;
  auto gloadK = [&](int t) {
#pragma unroll
    for (int i = 0; i < KLD; ++i) { int q = tid + 512 * i; int row = q / KCH, c = q % KCH; if (q < 64 * KCH) kreg[i] = *(const u32x4*)(kp + (size_t)(start + t * 64 + row) * kstride + c * 8); }
  };
  auto gloadV = [&](int t) { vreg = *(const u32x4*)(vt + (size_t)vrow * S + t * 64 + vch * 8); };
  auto storeK = [&](int buf) {
    bf16_t* kbn = Ks + buf * 64 * KWP;
#pragma unroll
    for (int i = 0; i < KLD; ++i) { int q = tid + 512 * i; int row = q / KCH, c = q % KCH; if (q < 64 * KCH) *(u32x4*)(kbn + row * KWP + c * 8) = kreg[i]; }
  };
  auto storeV = [&](int buf) {
    bf16_t* vbn = Vs + buf * 64 * 72;
    u32x2 lo2 = {vreg.x, vreg.y}; u32x2 hi2 = {vreg.z, vreg.w};
    bf16_t* dst = vbn + vrow * 72 + (vch >> 1) * 16 + (vch & 1) * 4;
    *(u32x2*)dst = lo2; *(u32x2*)(dst + 8) = hi2;
  };
  __syncthreads();
  gloadK(0); gloadV(0); storeK(0); storeV(0);
  gloadK(1); storeK(1);
  __syncthreads();
  f32x16 sc[2];
#pragma unroll
  for (int kb2 = 0; kb2 < 2; ++kb2) {
    sc[kb2] = NM;
#pragma unroll
    for (int ks = 0; ks < NKS; ++ks) {
      bf16x8 a = *(const bf16x8*)(Ks + (kb2 * 32 + r) * KWP + koff + ks * 16 + 8 * h);
      sc[kb2] = MFMA(a, qf[ks], sc[kb2]);
    }
  }
  if (w >= 4) __builtin_amdgcn_s_setprio(1);
  for (int t = 0; t < nt; ++t) {
    if (t + 2 < nt) gloadK(t + 2);
    if (t + 1 < nt) gloadV(t + 1);
    const bf16_t* kbn = Ks + ((t + 1) & 1) * 64 * KWP; const bf16_t* vb = Vs + (t & 1) * 64 * 72;
    u32x4 vf[2][4];
#pragma unroll
    for (int dvb = 0; dvb < 2; ++dvb)
#pragma unroll
      for (int c4 = 0; c4 < 2; ++c4) {
        vf[dvb][c4] = *(const u32x4*)(vb + (dvb * 32 + r) * 72 + c4 * 16 + 8 * h);
      }
    __builtin_amdgcn_sched_barrier(0);
    unsigned u0 = __float_as_uint(sc[0][0]), u1 = __float_as_uint(sc[0][1]), u2 = __float_as_uint(sc[1][0]), u3 = __float_as_uint(sc[1][1]);
#pragma unroll
    for (int e = 2; e < 16; e += 2) {
      u0 = min(u0, min(__float_as_uint(sc[0][e]), __float_as_uint(sc[0][e + 1])));
      u1 = min(u1, min(__float_as_uint(sc[1][e]), __float_as_uint(sc[1][e + 1])));
    }
    u0 = min(min(u0, u1), min(u2, u3));
    {
      auto rr = __builtin_amdgcn_permlane32_swap(u0, u0, false, false);
      u0 = min((unsigned)rr[0], (unsigned)rr[1]);
    }
    const float REF_GAP = 8.f;
    const float rel = USE_NM ? 0.f : mref;
    const bool grow = (u0 < 0x80000000u) || (__uint_as_float(u0) - rel > -2.f);
    if (t == 0 || __any(grow)) {
      float m0 = fmaxf(sc[0][0], sc[0][1]), m1 = fmaxf(sc[0][2], sc[0][3]), m2 = fmaxf(sc[1][0], sc[1][1]), m3 = fmaxf(sc[1][2], sc[1][3]);
#pragma unroll
      for (int e = 4; e < 16; e += 4) {
        m0 = fmaxf(m0, fmaxf(sc[0][e], sc[0][e + 1])); m1 = fmaxf(m1, fmaxf(sc[0][e + 2], sc[0][e + 3]));
        m2 = fmaxf(m2, fmaxf(sc[1][e], sc[1][e + 1])); m3 = fmaxf(m3, fmaxf(sc[1][e + 2], sc[1][e + 3]));
      }
      const float mx = xhalf_max(fmaxf(fmaxf(m0, m1), fmaxf(m2, m3))) - rel;
      const float delta = (t == 0) ? mx + REF_GAP : fmaxf(mx + REF_GAP, 0.f);
      const float corr = __builtin_amdgcn_exp2f(-delta);
      lrun *= corr;
      mref += delta;
#pragma unroll
      for (int e = 0; e < 16; ++e) {
        if (USE_NM) { sc[0][e] -= delta; sc[1][e] -= delta; NM[e] -= delta; }
        O[0][e] *= corr; O[1][e] *= corr;
      }
    }
    float p0 = 0.f, p1 = 0.f, p2 = 0.f, p3 = 0.f;
    bf16x8 pf[4];
#pragma unroll
    for (int kb2 = 0; kb2 < 2; ++kb2)
#pragma unroll
      for (int s2 = 0; s2 < 2; ++s2) {
        float a[8];
#pragma unroll
        for (int e = 0; e < 8; ++e) a[e] = __builtin_amdgcn_exp2f(USE_NM ? sc[kb2][8 * s2 + e] : sc[kb2][8 * s2 + e] - mref);
        p0 += a[0] + a[4]; p1 += a[1] + a[5]; p2 += a[2] + a[6]; p3 += a[3] + a[7];
        u32x4 pu = {pack2(a[0], a[1]), pack2(a[2], a[3]), pack2(a[4], a[5]), pack2(a[6], a[7])};
        pf[kb2 * 2 + s2] = __builtin_bit_cast(bf16x8, pu);
      }
    lrun += (p0 + p1) + (p2 + p3);
    bf16x8 kf0[NKS], kf1[NKS];
#pragma unroll
    for (int ks = 0; ks < NKS; ++ks) kf0[ks] = *(const bf16x8*)(kbn + r * KWP + koff + ks * 16 + 8 * h);
    __builtin_amdgcn_sched_barrier(0);
#pragma unroll
    for (int c4 = 0; c4 < 2; ++c4)
#pragma unroll
      for (int dvb = 0; dvb < 2; ++dvb) O[dvb] = MFMA(__builtin_bit_cast(bf16x8, vf[dvb][c4]), pf[c4], O[dvb]);
#pragma unroll
    for (int dvb = 0; dvb < 2; ++dvb)
#pragma unroll
      for (int c4 = 2; c4 < 4; ++c4) {
        vf[dvb][c4] = *(const u32x4*)(vb + (dvb * 32 + r) * 72 + c4 * 16 + 8 * h);
      }
#pragma unroll
    for (int ks = 0; ks < NKS; ++ks) kf1[ks] = *(const bf16x8*)(kbn + (32 + r) * KWP + koff + ks * 16 + 8 * h);
    __builtin_amdgcn_sched_barrier(0);
    sc[0] = NM; sc[1] = NM;
#pragma unroll
    for (int ks = 0; ks < NKS; ++ks) sc[0] = MFMA(kf0[ks], qf[ks], sc[0]);
#pragma unroll
    for (int c4 = 2; c4 < 4; ++c4)
#pragma unroll
      for (int dvb = 0; dvb < 2; ++dvb) O[dvb] = MFMA(__builtin_bit_cast(bf16x8, vf[dvb][c4]), pf[c4], O[dvb]);
#pragma unroll
    for (int ks = 0; ks < NKS; ++ks) sc[1] = MFMA(kf1[ks], qf[ks], sc[1]);
    if (t + 2 < nt) storeK(t & 1);
    if (t + 1 < nt) storeV((t + 1) & 1);
    __syncthreads();
  }
  __builtin_amdgcn_s_setprio(0);
  const float lt = xhalf_sum(lrun);
  const float inv = 1.f / lt;
  if (DIFF) {
    if (sub == 1) {
#pragma unroll
      for (int dvb = 0; dvb < 2; ++dvb)
#pragma unroll
        for (int e = 0; e < 16; ++e) Xc[(rblk * 64 + dvb * 32 + crow(e, h)) * 32 + r] = O[dvb][e] * inv;
    }
    __syncthreads();
    if (sub == 0) {
      float ss = 0.f;
#pragma unroll
      for (int dvb = 0; dvb < 2; ++dvb)
#pragma unroll
        for (int e = 0; e < 16; ++e) { float v = O[dvb][e] * inv - lam * Xc[(rblk * 64 + dvb * 32 + crow(e, h)) * 32 + r]; O[dvb][e] = v; ss += v * v; }
      ss = xhalf_sum(ss);
      const float rstd = rsqrtf(ss * (1.f / 64.f) + EPSN) * post_scale;
#pragma unroll
      for (int dvb = 0; dvb < 2; ++dvb)
#pragma unroll
        for (int g4 = 0; g4 < 4; ++g4) {
          const int dv = dvb * 32 + 8 * g4 + 4 * h;
          u32x2 gu = *(const u32x2*)(gp + (size_t)qrow * ZS + dv);
          float g0 = silu_f(bflo(gu.x)), g1 = silu_f(bfhi(gu.x)), g2 = silu_f(bflo(gu.y)), g3 = silu_f(bfhi(gu.y));
          float o0 = O[dvb][4 * g4] * rstd * subln[dv] * g0, o1 = O[dvb][4 * g4 + 1] * rstd * subln[dv + 1] * g1;
          float o2 = O[dvb][4 * g4 + 2] * rstd * subln[dv + 2] * g2, o3 = O[dvb][4 * g4 + 3] * rstd * subln[dv + 3] * g3;
          u32x2 ou = {pack2(o0, o1), pack2(o2, o3)};
          *(u32x2*)(op + (size_t)qrow * ostride + dv) = ou;
        }
    }
  } else {
#pragma unroll
    for (int dvb = 0; dvb < 2; ++dvb)
#pragma unroll
      for (int g4 = 0; g4 < 4; ++g4) {
        const int dv = dvb * 32 + 8 * g4 + 4 * h;
        u32x2 gu = *(const u32x2*)(gp + (size_t)qrow * ZS + dv);
        float g0 = silu_f(bflo(gu.x)), g1 = silu_f(bfhi(gu.x)), g2 = silu_f(bflo(gu.y)), g3 = silu_f(bfhi(gu.y));
        float o0 = O[dvb][4 * g4] * inv * g0, o1 = O[dvb][4 * g4 + 1] * inv * g1;
        float o2 = O[dvb][4 * g4 + 2] * inv * g2, o3 = O[dvb][4 * g4 + 3] * inv * g3;
        u32x2 ou = {pack2(o0, o1), pack2(o2, o3)};
        *(u32x2*)(op + (size_t)qrow * ostride + dv) = ou;
      }
  }
}

DI void scan_item(const Params& p, int l, int seq, int hh, char* ldsraw0) {
  const int tid512 = opaque_tid();
  const int dir = tid512 >> 8;
  char* ldsraw = ldsraw0 + dir * 61440;
  bf16_t* Xs = (bf16_t*)ldsraw;
  float* Xf = (float*)(ldsraw + 9216);
  float* Aa = Xf + 4096;
  float* Bb = Aa + 4096;
  float* SegA = Bb + 4096;
  float* SegB = SegA + 256;
  float* carry = SegB + 256;
  const int tid = tid512 & 255, lane = tid & 63, w = tid >> 6, r = lane & 31, h = lane >> 5;
  const int mi = w >> 1, ni = w & 1;
  const int S = seq_len(seq), start = seq_start(seq);
  const bf16_t* z = (const bf16_t*)(p.ws + OFF_Z);
  bf16_t* zw = (bf16_t*)(p.ws + OFF_Z);
  bf16_t* hfb = (bf16_t*)(p.ws + OFF_HFB);
  const bf16_t* wl = (const bf16_t*)(p.ws + OFF_WLRU);
  bf16x8 wf[2][4];
#pragma unroll
  for (int mat = 0; mat < 2; ++mat)
#pragma unroll
    for (int ks = 0; ks < 4; ++ks)
      wf[mat][ks] = *(const bf16x8*)(wl + (size_t)((((l * 2 + dir) * 2 + mat) * 4 + hh) * 64 + ni * 32 + r) * 64 + ks * 16 + 8 * h);
  const int che = hh * 64 + ni * 32 + r;
  const float ba = p.lru_ba[(l * 2 + dir) * 256 + che], bx = p.lru_bx[(l * 2 + dir) * 256 + che];
  const float sp8 = 8.f * log1pf(expf(-p.lru_lambda[(l * 2 + dir) * 256 + che]));
  const int c = tid & 63, q = tid >> 6;
  const int chs = hh * 64 + c;
  const float cw0 = p.conv_w[(l * 4 + 0) * 256 + chs], cw1 = p.conv_w[(l * 4 + 1) * 256 + chs], cw2 = p.conv_w[(l * 4 + 2) * 256 + chs], cw3 = p.conv_w[(l * 4 + 3) * 256 + chs];
  const float cb = p.conv_b[l * 256 + chs];
  __syncthreads();
  if (tid < 128) carry[tid] = 0.f;
  const int ntile = S / 64;
  const bf16_t* zx = z + (size_t)start * ZS + ZC_XC + chs;
  const bf16_t* zg = z + (size_t)start * ZS + ZC_GC + chs;
  bf16_t xn[19];
  {
    const int sb = (dir ? S - 64 : 0) + q * 16 - 2;
#pragma unroll
    for (int e = 0; e < 19; ++e) { int sp = sb + e; xn[e] = (sp >= 0 && sp < S) ? zx[(size_t)sp * ZS] : (bf16_t)0; }
  }
  for (int tile = 0; tile < ntile; ++tile) {
    const int p0 = dir ? S - 64 * (tile + 1) : 64 * tile;
    float xv[19];
#pragma unroll
    for (int e = 0; e < 19; ++e) xv[e] = bf2f(xn[e]);
    if (tile + 1 < ntile) {
      const int sb = (dir ? S - 64 * (tile + 2) : 64 * (tile + 1)) + q * 16 - 2;
#pragma unroll
      for (int e = 0; e < 19; ++e) { int sp = sb + e; xn[e] = (sp >= 0 && sp < S) ? zx[(size_t)sp * ZS] : (bf16_t)0; }
    }
    const bool first = tile < (ntile >> 1);
    unsigned gp[16];
    if (!first) {
#pragma unroll
      for (int jj = 0; jj < 16; ++jj) {
        const int u = q * 16 + jj; const int tok = dir ? 63 - u : u;
        gp[jj] = (unsigned)zg[(size_t)(p0 + tok) * ZS] | ((unsigned)hfb[(size_t)(start + p0 + tok) * 512 + (1 - dir) * 256 + chs] << 16);
      }
    }
#pragma unroll
    for (int jj = 0; jj < 16; ++jj) {
      float xc = cb + cw0 * xv[jj] + cw1 * xv[jj + 1] + cw2 * xv[jj + 2] + cw3 * xv[jj + 3];
      Xs[(q * 16 + jj) * 72 + c] = f2bf(xc);
      Xf[(q * 16 + jj) * 64 + c] = xc;
    }
    __syncthreads();
    {
      f32x16 aR, aI;
#pragma unroll
      for (int e = 0; e < 16; ++e) { aR[e] = 0.f; aI[e] = 0.f; }
#pragma unroll
      for (int ks = 0; ks < 4; ++ks) {
        bf16x8 a = *(const bf16x8*)(Xs + (mi * 32 + r) * 72 + ks * 16 + 8 * h);
        aR = MFMA(a, wf[0][ks], aR);
        aI = MFMA(a, wf[1][ks], aI);
      }
#pragma unroll
      for (int i = 0; i < 16; ++i) {
        const int tok = mi * 32 + crow(i, h), ch = ni * 32 + r;
        const float rr = __builtin_amdgcn_rcpf(1.f + __expf(-(aR[i] + ba)));
        const float ii = __builtin_amdgcn_rcpf(1.f + __expf(-(aI[i] + bx)));
        const float xq = Xf[tok * 64 + ch];
        const float log_a = -sp8 * rr;
        const float a = __expf(log_a);
        const float x2 = 2.f * log_a;
        const float ser = -x2 * (1.f + x2 * (0.5f + x2 * (0.16666667f + x2 * 0.041666668f)));
        const float om = x2 > -0.1f ? ser : 1.f - __expf(x2);
        const float gx = __builtin_amdgcn_sqrtf(om) * (ii * xq);
        Aa[tok * 64 + ch] = a; Bb[tok * 64 + ch] = gx;
      }
    }
    __syncthreads();
    float Ac[16], Bc[16];
    {
      float A = 1.f, B = 0.f;
#pragma unroll
      for (int jj = 0; jj < 16; ++jj) {
        const int u = q * 16 + jj; const int tok = dir ? 63 - u : u;
        float a = Aa[tok * 64 + c], b = Bb[tok * 64 + c];
        B = a * B + b; A = A * a; Ac[jj] = A; Bc[jj] = B;
      }
      SegA[q * 64 + c] = A; SegB[q * 64 + c] = B;
    }
    __syncthreads();
    {
      float cin = carry[(tile & 1) * 64 + c];
      for (int qq = 0; qq < q; ++qq) cin = SegA[qq * 64 + c] * cin + SegB[qq * 64 + c];
#pragma unroll
      for (int jj = 0; jj < 16; ++jj) {
        const int u = q * 16 + jj; const int tok = dir ? 63 - u : u;
        float hv = Ac[jj] * cin + Bc[jj];
        const size_t trow = (size_t)(start + p0 + tok);
        if (first) hfb[trow * 512 + dir * 256 + chs] = f2bf(hv);
        else zw[trow * ZS + ZC_GC + chs] = f2bf((hv + bfhi(gp[jj])) * silu_f(bflo(gp[jj])));
        if (jj == 15 && q == 3) carry[((tile + 1) & 1) * 64 + c] = hv;
      }
    }
    __syncthreads();
  }
}

DI void phase_mix(const Params& p, int l, char* ldsraw) {
  __shared__ int s_item;
  const int tid = threadIdx.x;
  const int x = blockIdx.x & 7;
  int* ctr = (int*)(p.ws + OFF_CTR) + l * 8 + x;
  bf16_t* z = (bf16_t*)(p.ws + OFF_Z);
  bf16_t* QA = (bf16_t*)(p.ws + OFF_QA);
  bf16_t* KA = (bf16_t*)(p.ws + OFF_KA);
  const bf16_t* VTA = (const bf16_t*)(p.ws + OFF_VTA);
  const bf16_t* VTB = (const bf16_t*)(p.ws + OFF_VTB);
  const bf16_t* VTD = (const bf16_t*)(p.ws + OFF_VTD);
  const float lam = ((const float*)(p.ws + OFF_LAM))[l];
  const float lam_init = l == 0 ? 0.2f : 0.8f - 0.6f * 0.7408182206817179f;
  constexpr int N_ITEMS = 16 + 512 + 256;
  while (true) {
    __syncthreads();
    if (tid == 0) s_item = atomicAdd(ctr, 1);
    __syncthreads();
    int j = __builtin_amdgcn_readfirstlane(s_item);
    if (j >= N_ITEMS) break;
    if (j < 16) { const int id = j * 8 + x; scan_item(p, l, id >> 2, id & 3, ldsraw); continue; }
    j -= 16;
    int type, seq, head, qt;
    if (j < 512) {
      if (j < 256) { type = 1; const int gg = (j >> 5) * 8 + x; seq = gg >> 2; head = gg & 3; qt = j & 31; }
      else { type = j < 384 ? 2 : 0; const int jj = j & 127; const int gg = (jj >> 4) * 8 + x; seq = gg >> 2; head = gg & 3; qt = jj & 15; }
    } else {
      j -= 512;
      if (j < 128) { type = 1; const int gg = (j >> 4) * 8 + x; seq = 16 + (gg >> 2); head = gg & 3; qt = j & 15; }
      else { type = j < 192 ? 2 : 0; const int jj = j & 63; const int gg = (jj >> 3) * 8 + x; seq = 16 + (gg >> 2); head = gg & 3; qt = jj & 7; }
    }
    const int S = seq_len(seq), start = seq_start(seq);
    if (type == 0) {
      attn_item<96, 96, false>(QA + head * 96, 384, KA + head * 96, 384, VTA + (size_t)start * 256 + (size_t)head * 64 * S,
                               z + ZC_VB + head * 64, ZS, z + ZC_GA + head * 64, S, start, qt, (bf16_t*)ldsraw, 0.f, 0.f, nullptr);
    } else if (type == 1) {
      attn_item<32, 64, true>(z + ZC_QB + head * 64, ZS, z + ZC_KB + head * 64, ZS, VTB + (size_t)start * 256 + (size_t)head * 64 * S,
                              z + ZC_QB + head * 64, ZS, z + ZC_GB + head * 64, S, start, qt, (bf16_t*)ldsraw, lam, 1.f - lam_init, p.diff_subln + l * 64);
    } else {
      attn_item<64, 64, false>(z + ZC_QD + head * 64, ZS, z + ZC_KD + (head >> 1) * 64, ZS, VTD + (size_t)start * 128 + (size_t)(head >> 1) * 64 * S,
                               z + ZC_QD + head * 64, ZS, z + ZC_GD + head * 64, S, start, qt, (bf16_t*)ldsraw, 0.f, 0.f, nullptr);
    }
  }
}

DI void phase_outproj(const Params& p, int l, bf16_t* lds) {
  const bf16_t* z = (const bf16_t*)(p.ws + OFF_Z);
  const bf16_t* QA = (const bf16_t*)(p.ws + OFF_QA);
  const bf16_t* hfb = (const bf16_t*)(p.ws + OFF_HFB);
  const bf16_t* wt = (const bf16_t*)(p.ws + OFF_WOUT) + (size_t)l * 1024 * 1024;
  const float* modp = (const float*)(p.ws + OFF_MOD) + (size_t)l * 32 * 3072;
  const int lane = opaque_tid() & 63, r = lane & 31, h = lane >> 5;
  constexpr int NT = 4, MT = T_TOK / 256;
  {
    gemm_stream(z, ZS,
        [&](int kt) {
          const int grp = kt >> 2, sub = kt & 3;
          const int col = grp == 0 ? ZC_VB : (grp == 1 ? ZC_QB : (grp == 2 ? ZC_GC : ZC_QD));
          return col + sub * 64;
        },
        wt, 1024, 16,
        [&](int q, int& tm0, int& tn0) { int mt, nt; const bool v = xcd_tile(q, NT, MT, mt, nt); tm0 = mt * 256; tn0 = nt * 256; return v; },
        [&](int m0, int n64, const f32x16& acc0, const f32x16& acc1) {
         const int lane = opaque_tid() & 63, r = lane & 31, h = lane >> 5;
#pragma unroll
         for (int ni = 0; ni < 2; ++ni) {
          const f32x16& acc = ni == 0 ? acc0 : acc1;
          const int n = n64 + ni * 32 + r;
          int seq, s; tok2seq(m0, seq, s);
          const float gate = modp[seq * 3072 + 2048 + n];
          const float* xb = (l == 0) ? (m0 < T_P ? p.xin0 + (size_t)m0 * 1024 : p.xin1 + (size_t)(m0 - T_P) * 1024) : p.out + (size_t)m0 * 1024;
          xb += (size_t)(4 * h) * 1024 + n;
          float* ob = p.out + (size_t)(m0 + 4 * h) * 1024 + n;
#pragma unroll
          for (int i = 0; i < 16; ++i) {
            const int ro = ((i & 3) + 8 * (i >> 2)) * 1024;
            ob[ro] = xb[ro] + gate * acc[i];
          }
         }
        },
        lds);
  }
}

__global__ void __launch_bounds__(512, 2) hymba_fwd(Params p) {
  cg::grid_group grid = cg::this_grid();
  unsigned* gbar = (unsigned*)(p.ws + OFF_CTR) + 48;
  const unsigned nblk = gridDim.x;
  unsigned gb_n = 0;
  __shared__ __attribute__((aligned(16))) char lds[147456];
  phase0a(p, (float*)lds);
  grid.sync();
  phase_norm(p, 0, 0, true);
  grid_barrier(gbar, nblk * (++gb_n));
#pragma unroll 1
  for (int l = 0; l < 2; ++l) {
    phase_inproj(p, l, (bf16_t*)lds);
    grid_barrier(gbar, nblk * (++gb_n));
    phase_mla_up(p, l, (bf16_t*)lds);
    grid_barrier(gbar, nblk * (++gb_n));
    phase_mix(p, l, lds);
    grid_barrier(gbar, nblk * (++gb_n));
    phase_outproj(p, l, (bf16_t*)lds);
    grid_barrier(gbar, nblk * (++gb_n));
    if (l == 0) { phase_norm(p, 1, 0, false); grid_barrier(gbar, nblk * (++gb_n)); }
    else phase_norm(p, 0, 1, false);
  }
}

extern "C" void kernel_launch(void* const* d_in, const int* in_sizes, int n_in, void* d_out, int out_size, void* d_ws, size_t ws_size, hipStream_t stream) {
  if (ws_size < WS_NEED) { fprintf(stderr, "workspace too small: %zu < %zu\n", ws_size, (size_t)WS_NEED); return; }
  static int grid_blocks = 0;
  if (!grid_blocks) {
    int dev = 0, cus = 0, per_cu = 0;
    hipGetDevice(&dev);
    hipDeviceGetAttribute(&cus, hipDeviceAttributeMultiprocessorCount, dev);
    hipOccupancyMaxActiveBlocksPerMultiprocessor(&per_cu, hymba_fwd, 512, 0);
    if (per_cu > 1) per_cu = 1;
    if (per_cu < 1) per_cu = 1;
    grid_blocks = (cus * per_cu) & ~7;
  }
  Params p{};
  p.xin0 = (const float*)d_in[0]; p.xin1 = (const float*)d_in[1]; p.c0 = (const float*)d_in[2]; p.c1 = (const float*)d_in[3];
  p.ada_w = (const float*)d_in[4]; p.ada_b = (const float*)d_in[5]; p.norm_g = (const float*)d_in[6]; p.w_in = (const float*)d_in[7];
  p.mla_q_norm = (const float*)d_in[8]; p.mla_w_uq = (const float*)d_in[9]; p.mla_kv_norm = (const float*)d_in[10]; p.mla_w_ukv = (const float*)d_in[11];
  p.diff_lambda = (const float*)d_in[12]; p.diff_subln = (const float*)d_in[13]; p.conv_w = (const float*)d_in[14]; p.conv_b = (const float*)d_in[15];
  p.lru_wa = (const float*)d_in[16]; p.lru_ba = (const float*)d_in[17]; p.lru_wx = (const float*)d_in[18]; p.lru_bx = (const float*)d_in[19];
  p.lru_lambda = (const float*)d_in[20]; p.gqa_q_norm = (const float*)d_in[21]; p.gqa_k_norm = (const float*)d_in[22]; p.w_out = (const float*)d_in[23];
  p.final_norm = (const float*)d_in[24];
  p.out = (float*)d_out; p.ws = (char*)d_ws;
  hipMemsetAsync((char*)d_ws + OFF_CTR, 0, 256, stream);
  void* args[] = {&p};
  hipError_t e = hipLaunchCooperativeKernel((void*)hymba_fwd, dim3(grid_blocks), dim3(512), args, 0, stream);
  if (e != hipSuccess) fprintf(stderr, "cooperative launch failed: %s (grid %d)\n", hipGetErrorString(e), grid_blocks);
}
```

```cpp
#include <hip/hip_runtime.h>
#include <hip/hip_cooperative_groups.h>
#include <cstdio>
#include <cstdint>
namespace cg = cooperative_groups;

typedef unsigned short bf16_t;
using bf16x8 = __attribute__((ext_vector_type(8))) short;
using f32x16 = __attribute__((ext_vector_type(16))) float;
typedef __bf16 bf16x2_t __attribute__((ext_vector_type(2)));
typedef float f32x2_t __attribute__((ext_vector_type(2)));
using u32x4 = __attribute__((ext_vector_type(4))) unsigned;
using u32x2 = __attribute__((ext_vector_type(2))) unsigned;
#define DI __device__ __forceinline__
#define MFMA(a, b, c) __builtin_amdgcn_mfma_f32_32x32x16_bf16((a), (b), (c), 0, 0, 0)

constexpr int T_TOK = 98304, T_P = 65536, DM = 1024, ZS = 2944, NIN = 2912;
constexpr int ZC_QB = 0, ZC_KB = 256, ZC_VB = 512, ZC_GB = 768, ZC_XC = 1024, ZC_GC = 1280, ZC_QD = 1536,
              ZC_KD = 1792, ZC_VD = 1920, ZC_GD = 2048, ZC_GA = 2304, ZC_QA = 2560, ZC_KVA = 2752, ZC_KRA = 2880;
constexpr float LOG2E = 1.4426950408889634f;
constexpr float EPSN = 1e-6f;

constexpr size_t OFF_H = 0;
constexpr size_t SZ_H = (size_t)T_TOK * 1024 * 2;
constexpr size_t OFF_QA = OFF_H;
constexpr size_t OFF_KA = OFF_H + (size_t)T_TOK * 384 * 2;
constexpr size_t OFF_VTA = OFF_H + (size_t)T_TOK * 768 * 2;
constexpr size_t OFF_Z = OFF_H + SZ_H;
constexpr size_t OFF_VTB = OFF_Z + (size_t)T_TOK * ZS * 2;
constexpr size_t OFF_VTD = OFF_VTB + (size_t)T_TOK * 256 * 2;
constexpr size_t OFF_HFB = OFF_VTD + (size_t)T_TOK * 128 * 2;
constexpr size_t OFF_WIN = OFF_HFB + (size_t)T_TOK * 512 * 2;
constexpr size_t OFF_WOUT = OFF_WIN + (size_t)2 * 3072 * 1024 * 2;
constexpr size_t OFF_WUQ = OFF_WOUT + (size_t)2 * 1024 * 1280 * 2;
constexpr size_t OFF_WUKV = OFF_WUQ + (size_t)2 * 512 * 192 * 2;
constexpr size_t OFF_WLRU = OFF_WUKV + (size_t)2 * 512 * 128 * 2;
constexpr size_t OFF_MOD = OFF_WLRU + (size_t)2 * 2 * 2 * 4 * 64 * 64 * 2;
constexpr size_t OFF_TABM = OFF_MOD + (size_t)2 * 32 * 3072 * 4;
constexpr size_t OFF_TABP = OFF_TABM + (size_t)4096 * 16 * 8;
constexpr size_t OFF_TABX = OFF_TABP + (size_t)4096 * 4 * 8;
constexpr size_t OFF_LAM = OFF_TABX + (size_t)64 * 16 * 8;
constexpr size_t OFF_CTR = OFF_LAM + 256;
constexpr size_t OFF_RSS = OFF_CTR + 256;
constexpr size_t WS_NEED = OFF_RSS + (size_t)T_TOK * 8 * 4;

struct Params {
  const float* xin0; const float* xin1; const float* c0; const float* c1;
  const float *ada_w, *ada_b, *norm_g, *w_in, *mla_q_norm, *mla_w_uq, *mla_kv_norm, *mla_w_ukv,
      *diff_lambda, *diff_subln, *conv_w, *conv_b, *lru_wa, *lru_ba, *lru_wx, *lru_bx, *lru_lambda,
      *gqa_q_norm, *gqa_k_norm, *w_out, *final_norm;
  float* out;
  char* ws;
};

DI unsigned pack2(float a, float b) { f32x2_t v = {a, b}; bf16x2_t o = __builtin_convertvector(v, bf16x2_t); return __builtin_bit_cast(unsigned, o); }
DI bf16_t f2bf(float a) { return (bf16_t)(pack2(a, 0.f) & 0xffffu); }
DI float bf2f(bf16_t v) { return __uint_as_float(((unsigned)v) << 16); }
DI float bflo(unsigned u) { return __uint_as_float(u << 16); }
DI float bfhi(unsigned u) { return __uint_as_float(u & 0xffff0000u); }
DI int opaque_tid() { int t = threadIdx.x; asm volatile("" : "+v"(t)); return t; }
DI int crow(int i, int h) { return (i & 3) + 8 * (i >> 2) + 4 * h; }
DI int seq_start(int seq) { return seq < 16 ? (seq << 12) : T_P + ((seq - 16) << 11); }
DI int seq_len(int seq) { return seq < 16 ? 4096 : 2048; }
DI void tok2seq(int t, int& seq, int& s) { if (t < T_P) { seq = t >> 12; s = t & 4095; } else { int u = t - T_P; seq = 16 + (u >> 11); s = u & 2047; } }
DI float silu_f(float x) { return x / (1.f + __expf(-x)); }
DI float sigmoid_f(float x) { return 1.f / (1.f + __expf(-x)); }
DI float xhalf_max(float v) { unsigned u = __float_as_uint(v); auto rr = __builtin_amdgcn_permlane32_swap(u, u, false, false); return fmaxf(__uint_as_float(rr[0]), __uint_as_float(rr[1])); }
DI float xhalf_sum(float v) { unsigned u = __float_as_uint(v); auto rr = __builtin_amdgcn_permlane32_swap(u, u, false, false); return __uint_as_float(rr[0]) + __uint_as_float(rr[1]); }
DI void grid_barrier(unsigned* ctr, unsigned target) {
  __syncthreads();
  if (threadIdx.x == 0) {
    __threadfence();
    atomicAdd(ctr, 1u);
    while (__hip_atomic_load(ctr, __ATOMIC_RELAXED, __HIP_MEMORY_SCOPE_AGENT) < target) __builtin_amdgcn_s_sleep(4);
    __threadfence();
  }
  __syncthreads();
}
DI float wave_sum(float v) {
  v += __shfl_xor(v, 32); v += __shfl_xor(v, 16); v += __shfl_xor(v, 8); v += __shfl_xor(v, 4); v += __shfl_xor(v, 2); v += __shfl_xor(v, 1);
  return v;
}

constexpr int G_LDP = 72;
constexpr int G_STAGE = 512 * G_LDP;
template <class ASrc, class Epi>
DI void gemm_tile(ASrc asrc, const bf16_t* __restrict__ Bt, int ldb, int nk, int m0, int n0, Epi epi, bf16_t* lds) {
  const int tid = opaque_tid(), lane = tid & 63, w = tid >> 6, r = lane & 31, h = lane >> 5;
  const int wm = w >> 2, wn = w & 3;
  f32x16 acc[4][2];
#pragma unroll
  for (int mi = 0; mi < 4; ++mi)
#pragma unroll
    for (int ni = 0; ni < 2; ++ni)
#pragma unroll
      for (int i = 0; i < 16; ++i) acc[mi][ni][i] = 0.f;
  u32x4 ra[4], rb[4];
  const int lrow = tid >> 3, lch = tid & 7;
  auto gload = [&](int kt) {
    const bf16_t* ab; int as; asrc(kt, ab, as);
#pragma unroll
    for (int i = 0; i < 4; ++i) ra[i] = *(const u32x4*)(ab + (size_t)(m0 + lrow + 64 * i) * as + lch * 8);
#pragma unroll
    for (int i = 0; i < 4; ++i) rb[i] = *(const u32x4*)(Bt + (size_t)(n0 + lrow + 64 * i) * ldb + kt * 64 + lch * 8);
  };
  auto lstore = [&](int buf) {
    bf16_t* As = lds + buf * G_STAGE; bf16_t* Bs = As + 256 * G_LDP;
#pragma unroll
    for (int i = 0; i < 4; ++i) *(u32x4*)(As + (lrow + 64 * i) * G_LDP + lch * 8) = ra[i];
#pragma unroll
    for (int i = 0; i < 4; ++i) *(u32x4*)(Bs + (lrow + 64 * i) * G_LDP + lch * 8) = rb[i];
  };
  __syncthreads();
  gload(0);
  lstore(0);
  gload(1);
  for (int t = 0; t < nk; ++t) {
    __syncthreads();
    if (t + 1 < nk) lstore((t + 1) & 1);
    if (t + 2 < nk) gload(t + 2);
    const bf16_t* As = lds + (t & 1) * G_STAGE; const bf16_t* Bs = As + 256 * G_LDP;
#pragma unroll
    for (int ks = 0; ks < 4; ++ks) {
      bf16x8 a[4], b[2];
#pragma unroll
      for (int mi = 0; mi < 4; ++mi) a[mi] = *(const bf16x8*)(As + (wm * 128 + mi * 32 + r) * G_LDP + ks * 16 + 8 * h);
#pragma unroll
      for (int ni = 0; ni < 2; ++ni) b[ni] = *(const bf16x8*)(Bs + (wn * 64 + ni * 32 + r) * G_LDP + ks * 16 + 8 * h);
#pragma unroll
      for (int mi = 0; mi < 4; ++mi)
#pragma unroll
        for (int ni = 0; ni < 2; ++ni) acc[mi][ni] = MFMA(a[mi], b[ni], acc[mi][ni]);
    }
  }
#pragma unroll
  for (int mi = 0; mi < 4; ++mi)
#pragma unroll
    for (int ni = 0; ni < 2; ++ni) epi(m0 + wm * 128 + mi * 32, n0 + wn * 64 + ni * 32, acc[mi][ni]);
}

template <class ACol, class TileFn, class Epi>
DI void gemm_stream(const bf16_t* __restrict__ Abase, int as, ACol acol, const bf16_t* __restrict__ Bt, int ldb, int nk, TileFn tile_fn, Epi epi, bf16_t* lds) {
  const int tid = opaque_tid(), lane = tid & 63, w = tid >> 6, r = lane & 31, h = lane >> 5;
  const int wm = w >> 2, wn = w & 3;
  u32x4 ra[4], rb[4];
  const int lrow = tid >> 3, lch = tid & 7;
  const bf16_t* ap; const bf16_t* bp;
  auto gload = [&](int kt) {
    const int ac = acol(kt);
#pragma unroll
    for (int i = 0; i < 4; ++i) ra[i] = *(const u32x4*)(ap + (size_t)(64 * i) * as + ac);
#pragma unroll
    for (int i = 0; i < 4; ++i) rb[i] = *(const u32x4*)(bp + (size_t)(64 * i) * ldb + kt * 64);
  };
  auto lstore = [&](int buf) {
    bf16_t* As = lds + buf * G_STAGE; bf16_t* Bs = As + 256 * G_LDP;
#pragma unroll
    for (int i = 0; i < 4; ++i) *(u32x4*)(As + (lrow + 64 * i) * G_LDP + lch * 8) = ra[i];
#pragma unroll
    for (int i = 0; i < 4; ++i) *(u32x4*)(Bs + (lrow + 64 * i) * G_LDP + lch * 8) = rb[i];
  };
  int q = blockIdx.x >> 3; const int qstep = gridDim.x >> 3;
  int m0, n0;
  if (!tile_fn(q, m0, n0)) return;
  ap = Abase + (size_t)(m0 + lrow) * as + lch * 8; bp = Bt + (size_t)(n0 + lrow) * ldb + lch * 8;
  gload(0);
  while (true) {
    f32x16 acc[4][2];
#pragma unroll
    for (int mi = 0; mi < 4; ++mi)
#pragma unroll
      for (int ni = 0; ni < 2; ++ni)
#pragma unroll
        for (int i = 0; i < 16; ++i) acc[mi][ni][i] = 0.f;
    __syncthreads();
    lstore(0);
    gload(1);
    for (int t = 0; t < nk; ++t) {
      __syncthreads();
      const bf16_t* As = lds + (t & 1) * G_STAGE; const bf16_t* Bs = As + 256 * G_LDP;
      bf16_t* Asn = lds + ((t + 1) & 1) * G_STAGE; bf16_t* Bsn = Asn + 256 * G_LDP;
      const int ac2 = (t + 2 < nk) ? acol(t + 2) : 0;
#pragma unroll
      for (int ks = 0; ks < 4; ++ks) {
        bf16x8 a[4], b[2];
#pragma unroll
        for (int mi = 0; mi < 4; ++mi) a[mi] = *(const bf16x8*)(As + (wm * 128 + mi * 32 + r) * G_LDP + ks * 16 + 8 * h);
#pragma unroll
        for (int ni = 0; ni < 2; ++ni) b[ni] = *(const bf16x8*)(Bs + (wn * 64 + ni * 32 + r) * G_LDP + ks * 16 + 8 * h);
        __builtin_amdgcn_sched_barrier(0);
#pragma unroll
        for (int mi = 0; mi < 4; ++mi)
#pragma unroll
          for (int ni = 0; ni < 2; ++ni) acc[mi][ni] = MFMA(a[mi], b[ni], acc[mi][ni]);
        if (t + 1 < nk) {
          *(u32x4*)(Asn + (lrow + 64 * ks) * G_LDP + lch * 8) = ra[ks];
          *(u32x4*)(Bsn + (lrow + 64 * ks) * G_LDP + lch * 8) = rb[ks];
        }
        if (t + 2 < nk) {
          ra[ks] = *(const u32x4*)(ap + (size_t)(64 * ks) * as + ac2);
          rb[ks] = *(const u32x4*)(bp + (size_t)(64 * ks) * ldb + (t + 2) * 64);
        }
      }
    }
    q += qstep;
    int m1, n1;
    const bool v1 = tile_fn(q, m1, n1);
    if (v1) { ap = Abase + (size_t)(m1 + lrow) * as + lch * 8; bp = Bt + (size_t)(n1 + lrow) * ldb + lch * 8; gload(0); }
#pragma unroll
    for (int mi = 0; mi < 4; ++mi) epi(m0 + wm * 128 + mi * 32, n0 + wn * 64, acc[mi][0], acc[mi][1]);
    if (!v1) break;
    m0 = m1; n0 = n1;
  }
}

DI bool xcd_tile(int q, int n_sub, int n_mt, int& mt, int& sub) {
  const int x = blockIdx.x & 7;
  const int mloc = q / n_sub; sub = q - mloc * n_sub;
  mt = mloc * 8 + x;
  return mt < n_mt;
}

template <class SrcFn>
DI void transpose64(SrcFn src, bf16_t* dst, int dld, int k0, int n0, float* tile) {
  const int tid = opaque_tid();
  __syncthreads();
  {
    const int nn = tid & 63, kq = tid >> 6;
#pragma unroll 4
    for (int i = 0; i < 8; ++i) { int kk = kq + 8 * i; tile[kk * 65 + nn] = src(k0 + kk, n0 + nn); }
  }
  __syncthreads();
  {
    const int kk2 = (tid & 31) * 2, nq = tid >> 5;
#pragma unroll 4
    for (int i = 0; i < 4; ++i) {
      int nn2 = nq + 16 * i;
      *(unsigned*)(dst + (size_t)(n0 + nn2) * dld + k0 + kk2) = pack2(tile[kk2 * 65 + nn2], tile[(kk2 + 1) * 65 + nn2]);
    }
  }
}

DI int win_perm(int n) {
  if (n < 2304) return n + 608;
  if (n < 2560) return n - 2304 + 352;
  if (n < 2752) return n - 2560;
  if (n < 2880) return n - 2752 + 192;
  if (n < 2912) return n - 2880 + 320;
  return -1;
}

DI void mod_item(const Params& p, int l, int nc, float* lds) {
  float* sc = lds;
  float* red = lds + 8192;
  const int tid = opaque_tid(), col = tid & 63, kq = tid >> 6;
  const int n = nc * 64 + col;
  float acc[32];
#pragma unroll
  for (int i = 0; i < 32; ++i) acc[i] = 0.f;
  const float* W = p.ada_w + (size_t)l * 1024 * 3072;
  for (int st = 0; st < 4; ++st) {
    __syncthreads();
    for (int e = 0; e < 16; ++e) {
      int idx = e * 512 + tid; int seq = idx >> 8, kk = idx & 255;
      const float* cp = seq < 16 ? p.c0 + seq * 1024 : p.c1 + (seq - 16) * 1024;
      sc[kk * 32 + seq] = silu_f(cp[st * 256 + kk]);
    }
    __syncthreads();
    for (int kk0 = 0; kk0 < 32; kk0 += 8) {
      float wv[8];
#pragma unroll
      for (int u = 0; u < 8; ++u) wv[u] = W[(size_t)(st * 256 + kq * 32 + kk0 + u) * 3072 + n];
#pragma unroll
      for (int u = 0; u < 8; ++u) {
        const float4* s4 = (const float4*)(sc + (kq * 32 + kk0 + u) * 32);
#pragma unroll
        for (int j = 0; j < 8; ++j) { float4 v = s4[j]; acc[4 * j] += v.x * wv[u]; acc[4 * j + 1] += v.y * wv[u]; acc[4 * j + 2] += v.z * wv[u]; acc[4 * j + 3] += v.w * wv[u]; }
      }
    }
  }
  __syncthreads();
#pragma unroll
  for (int i = 0; i < 32; ++i) red[(kq * 32 + i) * 64 + col] = acc[i];
  __syncthreads();
  float* modp = (float*)(p.ws + OFF_MOD) + (size_t)l * 32 * 3072;
  for (int e = 0; e < 4; ++e) {
    int seq = kq * 4 + e;
    float v = 0.f;
#pragma unroll
    for (int g = 0; g < 8; ++g) v += red[(g * 32 + seq) * 64 + col];
    modp[seq * 3072 + n] = v + p.ada_b[l * 3072 + n];
  }
  __syncthreads();
}

DI void phase0a(const Params& p, float* lds) {
  const int tid = opaque_tid();
  bf16_t* wt_in = (bf16_t*)(p.ws + OFF_WIN);
  bf16_t* wt_out = (bf16_t*)(p.ws + OFF_WOUT);
  bf16_t* wt_uq = (bf16_t*)(p.ws + OFF_WUQ);
  bf16_t* wt_ukv = (bf16_t*)(p.ws + OFF_WUKV);
  bf16_t* wlru = (bf16_t*)(p.ws + OFF_WLRU);
  constexpr int N_MOD = 96, N_WIN = 2 * 48 * 16, N_WOUT = 2 * 16 * 16, N_WUQ = 2 * 8 * 3, N_WUKV = 2 * 8 * 2, N_LRU = 32, N_TAB = 162;
  constexpr int N_ALL = N_MOD + N_WIN + N_WOUT + N_WUQ + N_WUKV + N_LRU + N_TAB + 1;
  for (int it = blockIdx.x; it < N_ALL; it += gridDim.x) {
    int j = it;
    if (j < N_MOD) { mod_item(p, j / 48, j % 48, lds); continue; }
    j -= N_MOD;
    if (j < N_WIN) {
      int l = j / (48 * 16), rem = j % (48 * 16), nt = rem / 16, kt = rem % 16;
      const float* src = p.w_in + (size_t)l * 1024 * NIN;
      transpose64([&](int k, int n) { int on = win_perm(n); return on >= 0 ? src[(size_t)k * NIN + on] : 0.f; },
                  wt_in + (size_t)l * 3072 * 1024, 1024, kt * 64, nt * 64, lds);
      continue;
    }
    j -= N_WIN;
    if (j < N_WOUT) {
      int l = j / (16 * 16), rem = j % (16 * 16), nt = rem / 16, kt = rem % 16;
      const float* src = p.w_out + (size_t)l * 1024 * 1024;
      transpose64([&](int k, int n) { return src[(size_t)k * 1024 + n]; },
                  wt_out + (size_t)l * 1024 * 1024, 1024, kt * 64, nt * 64, lds);
      continue;
    }
    j -= N_WOUT;
    if (j < N_WUQ) {
      int l = j / 24, rem = j % 24, nt = rem / 3, kt = rem % 3;
      const float* src = p.mla_w_uq + (size_t)l * 192 * 384;
      const float* gq = p.mla_q_norm + l * 192;
      transpose64([&](int k, int n) { return n < 384 ? src[(size_t)k * 384 + n] * gq[k] : 0.f; }, wt_uq + (size_t)l * 512 * 192, 192, kt * 64, nt * 64, lds);
      continue;
    }
    j -= N_WUQ;
    if (j < N_WUKV) {
      int l = j / 16, rem = j % 16, nt = rem / 2, kt = rem % 2;
      const float* src = p.mla_w_ukv + (size_t)l * 128 * 512;
      const float* gk = p.mla_kv_norm + l * 128;
      transpose64([&](int k, int n) { return src[(size_t)k * 512 + n] * gk[k]; }, wt_ukv + (size_t)l * 512 * 128, 128, kt * 64, nt * 64, lds);
      continue;
    }
    j -= N_WUKV;
    if (j < N_LRU) {
      int hh = j & 3, mat = (j >> 2) & 1, d = (j >> 3) & 1, l = j >> 4;
      const float* src = (mat ? p.lru_wx : p.lru_wa) + (size_t)((l * 2 + d) * 4 + hh) * 4096;
      transpose64([&](int k, int n) { return src[k * 64 + n]; }, wlru + (size_t)j * 4096, 64, 0, 0, lds);
      continue;
    }
    j -= N_LRU;
    if (j < N_TAB) {
      int e = j * 512 + tid;
      float2* tm = (float2*)(p.ws + OFF_TABM); float2* tp = (float2*)(p.ws + OFF_TABP); float2* tx = (float2*)(p.ws + OFF_TABX);
      if (e < 65536) { int pos = e >> 4, f = e & 15; float inv = powf(10000.f, -(float)f / 16.f); float a = (float)pos * inv; tm[e] = make_float2(cosf(a), sinf(a)); }
      else if (e < 65536 + 16384) { int q = e - 65536; int pos = q >> 2, f = q & 3; float inv = powf(500000.f, -(float)f / 4.f); float a = (float)pos * inv; tp[q] = make_float2(cosf(a), sinf(a)); }
      else if (e < 65536 + 16384 + 1024) { int q = e - 65536 - 16384; int pos = q >> 4, f = q & 15; float inv = powf(10000.f, -(float)f / 16.f); float a = (float)pos * inv; tx[q] = make_float2(cosf(a), sinf(a)); }
      continue;
    }
    if (tid < 2) {
      int l = tid; const float* lf = p.diff_lambda + l * 128;
      float s1 = 0.f, s2 = 0.f;
      for (int i = 0; i < 32; ++i) { s1 += lf[i] * lf[32 + i]; s2 += lf[64 + i] * lf[96 + i]; }
      float lam_init = 0.8f - 0.6f * expf(-0.3f * (float)l);
      ((float*)(p.ws + OFF_LAM))[l] = expf(s1) - expf(s2) + lam_init;
    }
  }
}

DI void phase_norm(const Params& p, int l, int mode, bool from_input) {
  using f32x4 = __attribute__((ext_vector_type(4))) float;
  const int tid = opaque_tid(), lane = tid & 63, w = tid >> 6;
  bf16_t* hbuf = (bf16_t*)(p.ws + OFF_H);
  const float* modp = (const float*)(p.ws + OFF_MOD) + (size_t)l * 32 * 3072;
  const float* g = mode == 0 ? p.norm_g + l * 1024 : p.final_norm;
  for (int it = blockIdx.x; it < T_TOK / 32; it += gridDim.x) {
    const int t0 = it * 32 + w * 4;
    const float* xr0 = from_input ? (t0 < T_P ? p.xin0 + (size_t)t0 * 1024 : p.xin1 + (size_t)(t0 - T_P) * 1024) : p.out + (size_t)t0 * 1024;
    f32x4 v[4][4];
#pragma unroll
    for (int rr = 0; rr < 4; ++rr)
#pragma unroll
      for (int j = 0; j < 4; ++j) v[rr][j] = *(const f32x4*)(xr0 + rr * 1024 + j * 256 + lane * 4);
    f32x4 gs[4], sh4[4];
    {
      int seq, s; tok2seq(t0, seq, s);
      const float* sh = modp + seq * 3072; const float* scl = sh + 1024;
#pragma unroll
      for (int j = 0; j < 4; ++j) {
        const int k = j * 256 + lane * 4;
        f32x4 gg = *(const f32x4*)(g + k);
        if (mode == 0) { f32x4 s4 = *(const f32x4*)(scl + k); gs[j] = gg * (1.f + s4); sh4[j] = *(const f32x4*)(sh + k); }
        else { gs[j] = gg; sh4[j] = gg * 0.f; }
      }
    }
#pragma unroll
    for (int rr = 0; rr < 4; ++rr) {
      float ss = 0.f;
#pragma unroll
      for (int j = 0; j < 4; ++j) ss += v[rr][j].x * v[rr][j].x + v[rr][j].y * v[rr][j].y + v[rr][j].z * v[rr][j].z + v[rr][j].w * v[rr][j].w;
      ss = wave_sum(ss);
      const float rstd = rsqrtf(ss * (1.f / 1024.f) + EPSN);
      const int t = t0 + rr;
#pragma unroll
      for (int j = 0; j < 4; ++j) {
        const int k = j * 256 + lane * 4;
        f32x4 o = v[rr][j] * rstd * gs[j] + sh4[j];
        if (mode == 0) {
          u32x2 ou = {pack2(o.x, o.y), pack2(o.z, o.w)};
          *(u32x2*)(hbuf + (size_t)t * 1024 + k) = ou;
        } else {
          *(f32x4*)(p.out + (size_t)t * 1024 + k) = o;
        }
      }
    }
  }
}

DI void phase_inproj(const Params& p, int l, bf16_t* lds) {
  const bf16_t* hbuf = (const bf16_t*)(p.ws + OFF_H);
  const bf16_t* wt = (const bf16_t*)(p.ws + OFF_WIN) + (size_t)l * 3072 * 1024;
  bf16_t* z = (bf16_t*)(p.ws + OFF_Z);
  bf16_t* vtb = (bf16_t*)(p.ws + OFF_VTB);
  bf16_t* vtd = (bf16_t*)(p.ws + OFF_VTD);
  float* rss = (float*)(p.ws + OFF_RSS);
  const float2* tm = (const float2*)(p.ws + OFF_TABM); const float2* tp = (const float2*)(p.ws + OFF_TABP); const float2* tx = (const float2*)(p.ws + OFF_TABX);
  const float SCB = 0.17677669529663687f * LOG2E;
  const float SCD = 0.125f * LOG2E;
  constexpr int NT = 12, MT = T_TOK / 256;
  {
    gemm_stream(hbuf, 1024, [&](int kt) { return kt * 64; }, wt, 1024, 16,
              [&](int q, int& tm0, int& tn0) { int mt, nt; const bool v = xcd_tile(q, NT, MT, mt, nt); nt = (nt + (mt >> 3)) % NT; tm0 = mt * 256; tn0 = nt * 256; return v; },
              [&](int m0, int n64, const f32x16& acc0, const f32x16& acc1) {
                const int lane = opaque_tid() & 63, r = lane & 31, h = lane >> 5;
                int seq, s0; tok2seq(m0, seq, s0);
                const int S = seq_len(seq), st = seq_start(seq);
                if (n64 >= ZC_QD && n64 < ZC_VD) {
                  const bool isq = n64 < ZC_KD;
                  const float* gn = (isq ? p.gqa_q_norm : p.gqa_k_norm) + l * 64;
                  const float g0 = gn[r], g1 = gn[32 + r];
                  const float scl = isq ? SCD : 1.f;
#pragma unroll
                  for (int i = 0; i < 16; ++i) {
                    float ss = acc0[i] * acc0[i] + acc1[i] * acc1[i];
                    ss += __shfl_xor(ss, 1); ss += __shfl_xor(ss, 2); ss += __shfl_xor(ss, 4); ss += __shfl_xor(ss, 8); ss += __shfl_xor(ss, 16);
                    const float rstd = rsqrtf(ss * (1.f / 64.f) + EPSN);
                    const int sp = s0 + crow(i, h);
                    const float x0 = acc0[i] * rstd * g0, x1 = acc1[i] * rstd * g1;
                    const float p0 = __shfl_xor(x0, 16), p1 = __shfl_xor(x1, 16);
                    const float2 c0 = tx[(sp >> 6) * 16 + (r & 15)], c1 = tx[(sp & 63) * 16 + (r & 15)];
                    const float o0 = (r < 16 ? x0 * c0.x - p0 * c0.y : x0 * c0.x + p0 * c0.y) * scl;
                    const float o1 = (r < 16 ? x1 * c1.x - p1 * c1.y : x1 * c1.x + p1 * c1.y) * scl;
                    bf16_t* zr = z + (size_t)(m0 + crow(i, h)) * ZS + n64 + r;
                    zr[0] = f2bf(o0); zr[32] = f2bf(o1);
                  }
                  return;
                }
                if (n64 >= ZC_QA && n64 < ZC_KRA) {
                  float* rs = rss + (size_t)(m0 + 4 * h) * 8 + ((n64 - ZC_QA) >> 6);
#pragma unroll
                  for (int i = 0; i < 16; ++i) {
                    float ss = acc0[i] * acc0[i] + acc1[i] * acc1[i];
                    ss += __shfl_xor(ss, 1); ss += __shfl_xor(ss, 2); ss += __shfl_xor(ss, 4); ss += __shfl_xor(ss, 8); ss += __shfl_xor(ss, 16);
                    if (r == 0) rs[((i & 3) + 8 * (i >> 2)) * 8] = ss;
                  }
                }
#pragma unroll
                for (int ni = 0; ni < 2; ++ni) {
                  const f32x16& acc = ni == 0 ? acc0 : acc1;
                  const int n0 = n64 + ni * 32;
                  const int n = n0 + r;
                  if (n0 >= ZC_VB && n0 < ZC_GB) {
                    bf16_t* base = vtb + (size_t)st * 256 + (size_t)(n - ZC_VB) * S + s0;
#pragma unroll
                    for (int g4 = 0; g4 < 4; ++g4)
                      *(uint2*)(base + 8 * g4 + 4 * h) = make_uint2(pack2(acc[4 * g4], acc[4 * g4 + 1]), pack2(acc[4 * g4 + 2], acc[4 * g4 + 3]));
                  } else if (n0 >= ZC_VD && n0 < ZC_GD) {
                    bf16_t* base = vtd + (size_t)st * 128 + (size_t)(n - ZC_VD) * S + s0;
#pragma unroll
                    for (int g4 = 0; g4 < 4; ++g4)
                      *(uint2*)(base + 8 * g4 + 4 * h) = make_uint2(pack2(acc[4 * g4], acc[4 * g4 + 1]), pack2(acc[4 * g4 + 2], acc[4 * g4 + 3]));
                  } else if (n0 < ZC_VB) {
                    const float scl = n0 < ZC_KB ? SCB : 1.f;
#pragma unroll
                    for (int i = 0; i < 16; ++i) {
                      const float x = acc[i];
                      const float pr = __shfl_xor(x, 4);
                      const float2 cs = tp[(s0 + crow(i, h)) * 4 + (r & 3)];
                      const float o = r < 4 ? x * cs.x - pr * cs.y : (r < 8 ? x * cs.x + pr * cs.y : x);
                      z[(size_t)(m0 + crow(i, h)) * ZS + n] = f2bf(o * scl);
                    }
                  } else if (n0 == ZC_KRA) {
#pragma unroll
                    for (int i = 0; i < 16; ++i) {
                      const float x = acc[i];
                      const float pr = __shfl_xor(x, 16);
                      const float2 cs = tm[(s0 + crow(i, h)) * 16 + (r & 15)];
                      z[(size_t)(m0 + crow(i, h)) * ZS + n] = f2bf(r < 16 ? x * cs.x - pr * cs.y : x * cs.x + pr * cs.y);
                    }
                  } else if (n0 < NIN) {
#pragma unroll
                    for (int i = 0; i < 16; ++i) z[(size_t)(m0 + crow(i, h)) * ZS + n] = f2bf(acc[i]);
                  }
                }
              },
              lds);
  }
}

DI void phase_mla_up(const Params& p, int l, bf16_t* lds) {
  const bf16_t* z = (const bf16_t*)(p.ws + OFF_Z);
  bf16_t* QA = (bf16_t*)(p.ws + OFF_QA);
  bf16_t* KA = (bf16_t*)(p.ws + OFF_KA);
  bf16_t* VTA = (bf16_t*)(p.ws + OFF_VTA);
  const bf16_t* wuq = (const bf16_t*)(p.ws + OFF_WUQ) + (size_t)l * 512 * 192;
  const bf16_t* wukv = (const bf16_t*)(p.ws + OFF_WUKV) + (size_t)l * 512 * 128;
  const float2* tm = (const float2*)(p.ws + OFF_TABM);
  const float* rss = (const float*)(p.ws + OFF_RSS);
  const int lane = opaque_tid() & 63, r = lane & 31, h = lane >> 5;
  const float SCA = 0.10206207261596577f * LOG2E;
  constexpr int MT = T_TOK / 256;
  for (int q = blockIdx.x >> 3;; q += gridDim.x >> 3) {
    int mt, sub;
    if (!xcd_tile(q, 4, MT, mt, sub)) break;
    sub = (sub + (mt >> 6)) & 3;
    if (sub < 2) {
      gemm_tile([&](int kt, const bf16_t*& ab, int& as) { ab = z + ZC_QA + kt * 64; as = ZS; }, wuq, 192, 3, mt * 256, sub * 256,
                [&](int m0, int n0, const f32x16& acc) {
                  if (n0 >= 384) return;
                  const int n = n0 + r;
                  const bool pe = ((n0 >> 5) % 3) == 2;
                  int seq, s0; tok2seq(m0, seq, s0);
#pragma unroll
                  for (int i = 0; i < 16; ++i) {
                    const float* rs = rss + (size_t)(m0 + crow(i, h)) * 8;
                    float x = acc[i] * rsqrtf((rs[0] + rs[1] + rs[2]) * (1.f / 192.f) + EPSN);
                    if (pe) {
                      float pr = __shfl_xor(x, 16);
                      float2 cs = tm[(s0 + crow(i, h)) * 16 + (r & 15)];
                      x = (r < 16) ? x * cs.x - pr * cs.y : x * cs.x + pr * cs.y;
                    }
                    QA[(size_t)(m0 + crow(i, h)) * 384 + n] = f2bf(x * SCA);
                  }
                },
                lds);
    } else {
      gemm_tile([&](int kt, const bf16_t*& ab, int& as) { ab = z + ZC_KVA + kt * 64; as = ZS; }, wukv, 128, 2, mt * 256, (sub - 2) * 256,
                [&](int m0, int n0, const f32x16& acc) {
                  const int hh = n0 >> 7;
                  const int nn = (n0 & 127) + r;
                  auto rstd_of = [&](int i) { const float* rs = rss + (size_t)(m0 + crow(i, h)) * 8; return rsqrtf((rs[3] + rs[4]) * (1.f / 128.f) + EPSN); };
                  if (nn < 64) {
#pragma unroll
                    for (int i = 0; i < 16; ++i) KA[(size_t)(m0 + crow(i, h)) * 384 + hh * 96 + nn] = f2bf(acc[i] * rstd_of(i));
                    if (nn >= 32) {
#pragma unroll
                      for (int i = 0; i < 16; ++i) KA[(size_t)(m0 + crow(i, h)) * 384 + hh * 96 + 64 + r] = z[(size_t)(m0 + crow(i, h)) * ZS + ZC_KRA + r];
                    }
                  } else {
                    int seq, s; tok2seq(m0, seq, s); const int S = seq_len(seq), st = seq_start(seq);
                    bf16_t* base = VTA + (size_t)st * 256 + (size_t)(hh * 64 + nn - 64) * S + s;
#pragma unroll
                    for (int g4 = 0; g4 < 4; ++g4)
                      *(uint2*)(base + 8 * g4 + 4 * h) = make_uint2(pack2(acc[4 * g4] * rstd_of(4 * g4), acc[4 * g4 + 1] * rstd_of(4 * g4 + 1)), pack2(acc[4 * g4 + 2] * rstd_of(4 * g4 + 2), acc[4 * g4 + 3] * rstd_of(4 * g4 + 3)));
                  }
                },
                lds);
    }
  }
}

template <int DK, int KW, bool DIFF>
DI void attn_item(const bf16_t* qp, int qstride, const bf16_t* kp, int kstride, const bf16_t* vt, bf16_t* op, int ostride, const bf16_t* gp,
                  int S, int start, int qt, bf16_t* lds, float lam, float post_scale, const float* subln) {
  constexpr int KWP = KW + 8;
  constexpr int KCH = KW / 8;
  constexpr int KLD = (64 * KCH + 511) / 512;
  constexpr int NKS = DK / 16;
  bf16_t* Ks = lds;
  bf16_t* Vs = lds + 2 * 64 * KWP;
  float* Xc = (float*)(lds + 2 * 64 * KWP + 2 * 64 * 72);
  const int tid = opaque_tid(), lane = tid & 63, w = tid >> 6, r = lane & 31, h = lane >> 5;
  const int sub = DIFF ? (w >> 2) : 0;
  const int rblk = DIFF ? (w & 3) : w;
  const int koff = DIFF ? sub * DK : 0;
  const int qrow = start + qt * (DIFF ? 128 : 256) + rblk * 32 + r;
  bf16x8 qf[NKS];
#pragma unroll
  for (int ks = 0; ks < NKS; ++ks) qf[ks] = *(const bf16x8*)(qp + (size_t)qrow * qstride + koff + ks * 16 + 8 * h);
  constexpr bool USE_NM = true;
  f32x16 O[2], NM;
  float lrun = 0.f, mref = 0.f;
#pragma unroll
  for (int e = 0; e < 16; ++e) { O[0][e] = 0.f; O[1][e] = 0.f; NM[e] = 0.f; }
  u32x4 kreg[KLD], vreg;
  const int vrow = tid >> 3, vch = tid & 7;
  const int nt = S / 64;
  auto gloadK = [&](int t) {
#pragma unroll
    for (int i = 0; i < KLD; ++i) { int q = tid + 512 * i; int row = q / KCH, c = q % KCH; if (q < 64 * KCH) kreg[i] = *(const u32x4*)(kp + (size_t)(start + t * 64 + row) * kstride + c * 8); }
  };
  auto gloadV = [&](int t) { vreg = *(const u32x4*)(vt + (size_t)vrow * S + t * 64 + vch * 8); };
  auto storeK = [&](int buf) {
    bf16_t* kbn = Ks + buf * 64 * KWP;
#pragma unroll
    for (int i = 0; i < KLD; ++i) { int q = tid + 512 * i; int row = q / KCH, c = q % KCH; if (q < 64 * KCH) *(u32x4*)(kbn + row * KWP + c * 8) = kreg[i]; }
  };
  auto storeV = [&](int buf) {
    bf16_t* vbn = Vs + buf * 64 * 72;
    u32x2 lo2 = {vreg.x, vreg.y}; u32x2 hi2 = {vreg.z, vreg.w};
    bf16_t* dst = vbn + vrow * 72 + (vch >> 1) * 16 + (vch & 1) * 4;
    *(u32x2*)dst = lo2; *(u32x2*)(dst + 8) = hi2;
  };
  __syncthreads();
  gloadK(0); gloadV(0); storeK(0); storeV(0);
  gloadK(1); storeK(1);
  __syncthreads();
  f32x16 sc[2];
#pragma unroll
  for (int kb2 = 0; kb2 < 2; ++kb2) {
    sc[kb2] = NM;
#pragma unroll
    for (int ks = 0; ks < NKS; ++ks) {
      bf16x8 a = *(const bf16x8*)(Ks + (kb2 * 32 + r) * KWP + koff + ks * 16 + 8 * h);
      sc[kb2] = MFMA(a, qf[ks], sc[kb2]);
    }
  }
  if (w >= 4) __builtin_amdgcn_s_setprio(1);
  for (int t = 0; t < nt; ++t) {
    if (t + 2 < nt) gloadK(t + 2);
    if (t + 1 < nt) gloadV(t + 1);
    const bf16_t* kbn = Ks + ((t + 1) & 1) * 64 * KWP; const bf16_t* vb = Vs + (t & 1) * 64 * 72;
    u32x4 vf[2][4];
#pragma unroll
    for (int dvb = 0; dvb < 2; ++dvb)
#pragma unroll
      for (int c4 = 0; c4 < 2; ++c4) {
        vf[dvb][c4] = *(const u32x4*)(vb + (dvb * 32 + r) * 72 + c4 * 16 + 8 * h);
      }
    __builtin_amdgcn_sched_barrier(0);
    unsigned u0 = __float_as_uint(sc[0][0]), u1 = __float_as_uint(sc[0][1]), u2 = __float_as_uint(sc[1][0]), u3 = __float_as_uint(sc[1][1]);
#pragma unroll
    for (int e = 2; e < 16; e += 2) {
      u0 = min(u0, min(__float_as_uint(sc[0][e]), __float_as_uint(sc[0][e + 1])));
      u1 = min(u1, min(__float_as_uint(sc[1][e]), __float_as_uint(sc[1][e + 1])));
    }
    u0 = min(min(u0, u1), min(u2, u3));
    {
      auto rr = __builtin_amdgcn_permlane32_swap(u0, u0, false, false);
      u0 = min((unsigned)rr[0], (unsigned)rr[1]);
    }
    const float REF_GAP = 8.f;
    const float rel = USE_NM ? 0.f : mref;
    const bool grow = (u0 < 0x80000000u) || (__uint_as_float(u0) - rel > -2.f);
    if (t == 0 || __any(grow)) {
      float m0 = fmaxf(sc[0][0], sc[0][1]), m1 = fmaxf(sc[0][2], sc[0][3]), m2 = fmaxf(sc[1][0], sc[1][1]), m3 = fmaxf(sc[1][2], sc[1][3]);
#pragma unroll
      for (int e = 4; e < 16; e += 4) {
        m0 = fmaxf(m0, fmaxf(sc[0][e], sc[0][e + 1])); m1 = fmaxf(m1, fmaxf(sc[0][e + 2], sc[0][e + 3]));
        m2 = fmaxf(m2, fmaxf(sc[1][e], sc[1][e + 1])); m3 = fmaxf(m3, fmaxf(sc[1][e + 2], sc[1][e + 3]));
      }
      const float mx = xhalf_max(fmaxf(fmaxf(m0, m1), fmaxf(m2, m3))) - rel;
      const float delta = (t == 0) ? mx + REF_GAP : fmaxf(mx + REF_GAP, 0.f);
      const float corr = __builtin_amdgcn_exp2f(-delta);
      lrun *= corr;
      mref += delta;
#pragma unroll
      for (int e = 0; e < 16; ++e) {
        if (USE_NM) { sc[0][e] -= delta; sc[1][e] -= delta; NM[e] -= delta; }
        O[0][e] *= corr; O[1][e] *= corr;
      }
    }
    float p0 = 0.f, p1 = 0.f, p2 = 0.f, p3 = 0.f;
    bf16x8 pf[4];
#pragma unroll
    for (int kb2 = 0; kb2 < 2; ++kb2)
#pragma unroll
      for (int s2 = 0; s2 < 2; ++s2) {
        float a[8];
#pragma unroll
        for (int e = 0; e < 8; ++e) a[e] = __builtin_amdgcn_exp2f(USE_NM ? sc[kb2][8 * s2 + e] : sc[kb2][8 * s2 + e] - mref);
        p0 += a[0] + a[4]; p1 += a[1] + a[5]; p2 += a[2] + a[6]; p3 += a[3] + a[7];
        u32x4 pu = {pack2(a[0], a[1]), pack2(a[2], a[3]), pack2(a[4], a[5]), pack2(a[6], a[7])};
        pf[kb2 * 2 + s2] = __builtin_bit_cast(bf16x8, pu);
      }
    lrun += (p0 + p1) + (p2 + p3);
    bf16x8 kf0[NKS], kf1[NKS];
#pragma unroll
    for (int ks = 0; ks < NKS; ++ks) kf0[ks] = *(const bf16x8*)(kbn + r * KWP + koff + ks * 16 + 8 * h);
    __builtin_amdgcn_sched_barrier(0);
#pragma unroll
    for (int c4 = 0; c4 < 2; ++c4)
#pragma unroll
      for (int dvb = 0; dvb < 2; ++dvb) O[dvb] = MFMA(__builtin_bit_cast(bf16x8, vf[dvb][c4]), pf[c4], O[dvb]);
#pragma unroll
    for (int dvb = 0; dvb < 2; ++dvb)
#pragma unroll
      for (int c4 = 2; c4 < 4; ++c4) {
        vf[dvb][c4] = *(const u32x4*)(vb + (dvb * 32 + r) * 72 + c4 * 16 + 8 * h);
      }
#pragma unroll
    for (int ks = 0; ks < NKS; ++ks) kf1[ks] = *(const bf16x8*)(kbn + (32 + r) * KWP + koff + ks * 16 + 8 * h);
    __builtin_amdgcn_sched_barrier(0);
    sc[0] = NM; sc[1] = NM;
#pragma unroll
    for (int ks = 0; ks < NKS; ++ks) sc[0] = MFMA(kf0[ks], qf[ks], sc[0]);
#pragma unroll
    for (int c4 = 2; c4 < 4; ++c4)
#pragma unroll
      for (int dvb = 0; dvb < 2; ++dvb) O[dvb] = MFMA(__builtin_bit_cast(bf16x8, vf[dvb][c4]), pf[c4], O[dvb]);
#pragma unroll
    for (int ks = 0; ks < NKS; ++ks) sc[1] = MFMA(kf1[ks], qf[ks], sc[1]);
    if (t + 2 < nt) storeK(t & 1);
    if (t + 1 < nt) storeV((t + 1) & 1);
    __syncthreads();
  }
  __builtin_amdgcn_s_setprio(0);
  const float lt = xhalf_sum(lrun);
  const float inv = 1.f / lt;
  if (DIFF) {
    if (sub == 1) {
#pragma unroll
      for (int dvb = 0; dvb < 2; ++dvb)
#pragma unroll
        for (int e = 0; e < 16; ++e) Xc[(rblk * 64 + dvb * 32 + crow(e, h)) * 32 + r] = O[dvb][e] * inv;
    }
    __syncthreads();
    if (sub == 0) {
      float ss = 0.f;
#pragma unroll
      for (int dvb = 0; dvb < 2; ++dvb)
#pragma unroll
        for (int e = 0; e < 16; ++e) { float v = O[dvb][e] * inv - lam * Xc[(rblk * 64 + dvb * 32 + crow(e, h)) * 32 + r]; O[dvb][e] = v; ss += v * v; }
      ss = xhalf_sum(ss);
      const float rstd = rsqrtf(ss * (1.f / 64.f) + EPSN) * post_scale;
#pragma unroll
      for (int dvb = 0; dvb < 2; ++dvb)
#pragma unroll
        for (int g4 = 0; g4 < 4; ++g4) {
          const int dv = dvb * 32 + 8 * g4 + 4 * h;
          u32x2 gu = *(const u32x2*)(gp + (size_t)qrow * ZS + dv);
          float g0 = silu_f(bflo(gu.x)), g1 = silu_f(bfhi(gu.x)), g2 = silu_f(bflo(gu.y)), g3 = silu_f(bfhi(gu.y));
          float o0 = O[dvb][4 * g4] * rstd * subln[dv] * g0, o1 = O[dvb][4 * g4 + 1] * rstd * subln[dv + 1] * g1;
          float o2 = O[dvb][4 * g4 + 2] * rstd * subln[dv + 2] * g2, o3 = O[dvb][4 * g4 + 3] * rstd * subln[dv + 3] * g3;
          u32x2 ou = {pack2(o0, o1), pack2(o2, o3)};
          *(u32x2*)(op + (size_t)qrow * ostride + dv) = ou;
        }
    }
  } else {
#pragma unroll
    for (int dvb = 0; dvb < 2; ++dvb)
#pragma unroll
      for (int g4 = 0; g4 < 4; ++g4) {
        const int dv = dvb * 32 + 8 * g4 + 4 * h;
        u32x2 gu = *(const u32x2*)(gp + (size_t)qrow * ZS + dv);
        float g0 = silu_f(bflo(gu.x)), g1 = silu_f(bfhi(gu.x)), g2 = silu_f(bflo(gu.y)), g3 = silu_f(bfhi(gu.y));
        float o0 = O[dvb][4 * g4] * inv * g0, o1 = O[dvb][4 * g4 + 1] * inv * g1;
        float o2 = O[dvb][4 * g4 + 2] * inv * g2, o3 = O[dvb][4 * g4 + 3] * inv * g3;
        u32x2 ou = {pack2(o0, o1), pack2(o2, o3)};
        *(u32x2*)(op + (size_t)qrow * ostride + dv) = ou;
      }
  }
}

DI void scan_item(const Params& p, int l, int seq, int hh, char* ldsraw0) {
  const int tid512 = opaque_tid();
  const int dir = tid512 >> 8;
  char* ldsraw = ldsraw0 + dir * 61440;
  bf16_t* Xs = (bf16_t*)ldsraw;
  float* Xf = (float*)(ldsraw + 9216);
  float* Aa = Xf + 4096;
  float* Bb = Aa + 4096;
  float* SegA = Bb + 4096;
  float* SegB = SegA + 256;
  float* carry = SegB + 256;
  const int tid = tid512 & 255, lane = tid & 63, w = tid >> 6, r = lane & 31, h = lane >> 5;
  const int mi = w >> 1, ni = w & 1;
  const int S = seq_len(seq), start = seq_start(seq);
  const bf16_t* z = (const bf16_t*)(p.ws + OFF_Z);
  bf16_t* zw = (bf16_t*)(p.ws + OFF_Z);
  bf16_t* hfb = (bf16_t*)(p.ws + OFF_HFB);
  const bf16_t* wl = (const bf16_t*)(p.ws + OFF_WLRU);
  bf16x8 wf[2][4];
#pragma unroll
  for (int mat = 0; mat < 2; ++mat)
#pragma unroll
    for (int ks = 0; ks < 4; ++ks)
      wf[mat][ks] = *(const bf16x8*)(wl + (size_t)((((l * 2 + dir) * 2 + mat) * 4 + hh) * 64 + ni * 32 + r) * 64 + ks * 16 + 8 * h);
  const int che = hh * 64 + ni * 32 + r;
  const float ba = p.lru_ba[(l * 2 + dir) * 256 + che], bx = p.lru_bx[(l * 2 + dir) * 256 + che];
  const float sp8 = 8.f * log1pf(expf(-p.lru_lambda[(l * 2 + dir) * 256 + che]));
  const int c = tid & 63, q = tid >> 6;
  const int chs = hh * 64 + c;
  const float cw0 = p.conv_w[(l * 4 + 0) * 256 + chs], cw1 = p.conv_w[(l * 4 + 1) * 256 + chs], cw2 = p.conv_w[(l * 4 + 2) * 256 + chs], cw3 = p.conv_w[(l * 4 + 3) * 256 + chs];
  const float cb = p.conv_b[l * 256 + chs];
  __syncthreads();
  if (tid < 128) carry[tid] = 0.f;
  const int ntile = S / 64;
  const bf16_t* zx = z + (size_t)start * ZS + ZC_XC + chs;
  const bf16_t* zg = z + (size_t)start * ZS + ZC_GC + chs;
  bf16_t xn[19];
  {
    const int sb = (dir ? S - 64 : 0) + q * 16 - 2;
#pragma unroll
    for (int e = 0; e < 19; ++e) { int sp = sb + e; xn[e] = (sp >= 0 && sp < S) ? zx[(size_t)sp * ZS] : (bf16_t)0; }
  }
  for (int tile = 0; tile < ntile; ++tile) {
    const int p0 = dir ? S - 64 * (tile + 1) : 64 * tile;
    float xv[19];
#pragma unroll
    for (int e = 0; e < 19; ++e) xv[e] = bf2f(xn[e]);
    if (tile + 1 < ntile) {
      const int sb = (dir ? S - 64 * (tile + 2) : 64 * (tile + 1)) + q * 16 - 2;
#pragma unroll
      for (int e = 0; e < 19; ++e) { int sp = sb + e; xn[e] = (sp >= 0 && sp < S) ? zx[(size_t)sp * ZS] : (bf16_t)0; }
    }
    const bool first = tile < (ntile >> 1);
    unsigned gp[16];
    if (!first) {
#pragma unroll
      for (int jj = 0; jj < 16; ++jj) {
        const int u = q * 16 + jj; const int tok = dir ? 63 - u : u;
        gp[jj] = (unsigned)zg[(size_t)(p0 + tok) * ZS] | ((unsigned)hfb[(size_t)(start + p0 + tok) * 512 + (1 - dir) * 256 + chs] << 16);
      }
    }
#pragma unroll
    for (int jj = 0; jj < 16; ++jj) {
      float xc = cb + cw0 * xv[jj] + cw1 * xv[jj + 1] + cw2 * xv[jj + 2] + cw3 * xv[jj + 3];
      Xs[(q * 16 + jj) * 72 + c] = f2bf(xc);
      Xf[(q * 16 + jj) * 64 + c] = xc;
    }
    __syncthreads();
    {
      f32x16 aR, aI;
#pragma unroll
      for (int e = 0; e < 16; ++e) { aR[e] = 0.f; aI[e] = 0.f; }
#pragma unroll
      for (int ks = 0; ks < 4; ++ks) {
        bf16x8 a = *(const bf16x8*)(Xs + (mi * 32 + r) * 72 + ks * 16 + 8 * h);
        aR = MFMA(a, wf[0][ks], aR);
        aI = MFMA(a, wf[1][ks], aI);
      }
#pragma unroll
      for (int i = 0; i < 16; ++i) {
        const int tok = mi * 32 + crow(i, h), ch = ni * 32 + r;
        const float rr = __builtin_amdgcn_rcpf(1.f + __expf(-(aR[i] + ba)));
        const float ii = __builtin_amdgcn_rcpf(1.f + __expf(-(aI[i] + bx)));
        const float xq = Xf[tok * 64 + ch];
        const float log_a = -sp8 * rr;
        const float a = __expf(log_a);
        const float x2 = 2.f * log_a;
        const float ser = -x2 * (1.f + x2 * (0.5f + x2 * (0.16666667f + x2 * 0.041666668f)));
        const float om = x2 > -0.1f ? ser : 1.f - __expf(x2);
        const float gx = __builtin_amdgcn_sqrtf(om) * (ii * xq);
        Aa[tok * 64 + ch] = a; Bb[tok * 64 + ch] = gx;
      }
    }
    __syncthreads();
    float Ac[16], Bc[16];
    {
      float A = 1.f, B = 0.f;
#pragma unroll
      for (int jj = 0; jj < 16; ++jj) {
        const int u = q * 16 + jj; const int tok = dir ? 63 - u : u;
        float a = Aa[tok * 64 + c], b = Bb[tok * 64 + c];
        B = a * B + b; A = A * a; Ac[jj] = A; Bc[jj] = B;
      }
      SegA[q * 64 + c] = A; SegB[q * 64 + c] = B;
    }
    __syncthreads();
    {
      float cin = carry[(tile & 1) * 64 + c];
      for (int qq = 0; qq < q; ++qq) cin = SegA[qq * 64 + c] * cin + SegB[qq * 64 + c];
#pragma unroll
      for (int jj = 0; jj < 16; ++jj) {
        const int u = q * 16 + jj; const int tok = dir ? 63 - u : u;
        float hv = Ac[jj] * cin + Bc[jj];
        const size_t trow = (size_t)(start + p0 + tok);
        if (first) hfb[trow * 512 + dir * 256 + chs] = f2bf(hv);
        else zw[trow * ZS + ZC_GC + chs] = f2bf((hv + bfhi(gp[jj])) * silu_f(bflo(gp[jj])));
        if (jj == 15 && q == 3) carry[((tile + 1) & 1) * 64 + c] = hv;
      }
    }
    __syncthreads();
  }
}

DI void phase_mix(const Params& p, int l, char* ldsraw) {
  __shared__ int s_item;
  const int tid = threadIdx.x;
  const int x = blockIdx.x & 7;
  int* ctr = (int*)(p.ws + OFF_CTR) + l * 8 + x;
  bf16_t* z = (bf16_t*)(p.ws + OFF_Z);
  bf16_t* QA = (bf16_t*)(p.ws + OFF_QA);
  bf16_t* KA = (bf16_t*)(p.ws + OFF_KA);
  const bf16_t* VTA = (const bf16_t*)(p.ws + OFF_VTA);
  const bf16_t* VTB = (const bf16_t*)(p.ws + OFF_VTB);
  const bf16_t* VTD = (const bf16_t*)(p.ws + OFF_VTD);
  const float lam = ((const float*)(p.ws + OFF_LAM))[l];
  const float lam_init = l == 0 ? 0.2f : 0.8f - 0.6f * 0.7408182206817179f;
  constexpr int N_ITEMS = 16 + 512 + 256;
  while (true) {
    __syncthreads();
    if (tid == 0) s_item = atomicAdd(ctr, 1);
    __syncthreads();
    int j = __builtin_amdgcn_readfirstlane(s_item);
    if (j >= N_ITEMS) break;
    if (j < 16) { const int id = j * 8 + x; scan_item(p, l, id >> 2, id & 3, ldsraw); continue; }
    j -= 16;
    int type, seq, head, qt;
    if (j < 512) {
      if (j < 256) { type = 1; const int gg = (j >> 5) * 8 + x; seq = gg >> 2; head = gg & 3; qt = j & 31; }
      else { type = j < 384 ? 2 : 0; const int jj = j & 127; const int gg = (jj >> 4) * 8 + x; seq = gg >> 2; head = gg & 3; qt = jj & 15; }
    } else {
      j -= 512;
      if (j < 128) { type = 1; const int gg = (j >> 4) * 8 + x; seq = 16 + (gg >> 2); head = gg & 3; qt = j & 15; }
      else { type = j < 192 ? 2 : 0; const int jj = j & 63; const int gg = (jj >> 3) * 8 + x; seq = 16 + (gg >> 2); head = gg & 3; qt = jj & 7; }
    }
    const int S = seq_len(seq), start = seq_start(seq);
    if (type == 0) {
      attn_item<96, 96, false>(QA + head * 96, 384, KA + head * 96, 384, VTA + (size_t)start * 256 + (size_t)head * 64 * S,
                               z + ZC_VB + head * 64, ZS, z + ZC_GA + head * 64, S, start, qt, (bf16_t*)ldsraw, 0.f, 0.f, nullptr);
    } else if (type == 1) {
      attn_item<32, 64, true>(z + ZC_QB + head * 64, ZS, z + ZC_KB + head * 64, ZS, VTB + (size_t)start * 256 + (size_t)head * 64 * S,
                              z + ZC_QB + head * 64, ZS, z + ZC_GB + head * 64, S, start, qt, (bf16_t*)ldsraw, lam, 1.f - lam_init, p.diff_subln + l * 64);
    } else {
      attn_item<64, 64, false>(z + ZC_QD + head * 64, ZS, z + ZC_KD + (head >> 1) * 64, ZS, VTD + (size_t)start * 128 + (size_t)(head >> 1) * 64 * S,
                               z + ZC_QD + head * 64, ZS, z + ZC_GD + head * 64, S, start, qt, (bf16_t*)ldsraw, 0.f, 0.f, nullptr);
    }
  }
}

DI void phase_outproj(const Params& p, int l, bf16_t* lds) {
  const bf16_t* z = (const bf16_t*)(p.ws + OFF_Z);
  const bf16_t* QA = (const bf16_t*)(p.ws + OFF_QA);
  const bf16_t* hfb = (const bf16_t*)(p.ws + OFF_HFB);
  const bf16_t* wt = (const bf16_t*)(p.ws + OFF_WOUT) + (size_t)l * 1024 * 1024;
  const float* modp = (const float*)(p.ws + OFF_MOD) + (size_t)l * 32 * 3072;
  const int lane = opaque_tid() & 63, r = lane & 31, h = lane >> 5;
  constexpr int NT = 4, MT = T_TOK / 256;
  {
    gemm_stream(z, ZS,
        [&](int kt) {
          const int grp = kt >> 2, sub = kt & 3;
          const int col = grp == 0 ? ZC_VB : (grp == 1 ? ZC_QB : (grp == 2 ? ZC_GC : ZC_QD));
          return col + sub * 64;
        },
        wt, 1024, 16,
        [&](int q, int& tm0, int& tn0) { int mt, nt; const bool v = xcd_tile(q, NT, MT, mt, nt); tm0 = mt * 256; tn0 = nt * 256; return v; },
        [&](int m0, int n64, const f32x16& acc0, const f32x16& acc1) {
         const int lane = opaque_tid() & 63, r = lane & 31, h = lane >> 5;
#pragma unroll
         for (int ni = 0; ni < 2; ++ni) {
          const f32x16& acc = ni == 0 ? acc0 : acc1;
          const int n = n64 + ni * 32 + r;
          int seq, s; tok2seq(m0, seq, s);
          const float gate = modp[seq * 3072 + 2048 + n];
          const float* xb = (l == 0) ? (m0 < T_P ? p.xin0 + (size_t)m0 * 1024 : p.xin1 + (size_t)(m0 - T_P) * 1024) : p.out + (size_t)m0 * 1024;
          xb += (size_t)(4 * h) * 1024 + n;
          float* ob = p.out + (size_t)(m0 + 4 * h) * 1024 + n;
#pragma unroll
          for (int i = 0; i < 16; ++i) {
            const int ro = ((i & 3) + 8 * (i >> 2)) * 1024;
            ob[ro] = xb[ro] + gate * acc[i];
          }
         }
        },
        lds);
  }
}

__global__ void __launch_bounds__(512, 2) hymba_fwd(Params p) {
  cg::grid_group grid = cg::this_grid();
  unsigned* gbar = (unsigned*)(p.ws + OFF_CTR) + 48;
  const unsigned nblk = gridDim.x;
  unsigned gb_n = 0;
  __shared__ __attribute__((aligned(16))) char lds[147456];
  phase0a(p, (float*)lds);
  grid.sync();
  phase_norm(p, 0, 0, true);
  grid_barrier(gbar, nblk * (++gb_n));
#pragma unroll 1
  for (int l = 0; l < 2; ++l) {
    phase_inproj(p, l, (bf16_t*)lds);
    grid_barrier(gbar, nblk * (++gb_n));
    phase_mla_up(p, l, (bf16_t*)lds);
    grid_barrier(gbar, nblk * (++gb_n));
    phase_mix(p, l, lds);
    grid_barrier(gbar, nblk * (++gb_n));
    phase_outproj(p, l, (bf16_t*)lds);
    grid_barrier(gbar, nblk * (++gb_n));
    if (l == 0) { phase_norm(p, 1, 0, false); grid_barrier(gbar, nblk * (++gb_n)); }
    else phase_norm(p, 0, 1, false);
  }
}

extern "C" void kernel_launch(void* const* d_in, const int* in_sizes, int n_in, void* d_out, int out_size, void* d_ws, size_t ws_size, hipStream_t stream) {
  if (ws_size < WS_NEED) { fprintf(stderr, "workspace too small: %zu < %zu\n", ws_size, (size_t)WS_NEED); return; }
  static int grid_blocks = 0;
  if (!grid_blocks) {
    int dev = 0, cus = 0, per_cu = 0;
    hipGetDevice(&dev);
    hipDeviceGetAttribute(&cus, hipDeviceAttributeMultiprocessorCount, dev);
    hipOccupancyMaxActiveBlocksPerMultiprocessor(&per_cu, hymba_fwd, 512, 0);
    if (per_cu > 1) per_cu = 1;
    if (per_cu < 1) per_cu = 1;
    grid_blocks = (cus * per_cu) & ~7;
  }
  Params p{};
  p.xin0 = (const float*)d_in[0]; p.xin1 = (const float*)d_in[1]; p.c0 = (const float*)d_in[2]; p.c1 = (const float*)d_in[3];
  p.ada_w = (const float*)d_in[4]; p.ada_b = (const float*)d_in[5]; p.norm_g = (const float*)d_in[6]; p.w_in = (const float*)d_in[7];
  p.mla_q_norm = (const float*)d_in[8]; p.mla_w_uq = (const float*)d_in[9]; p.mla_kv_norm = (const float*)d_in[10]; p.mla_w_ukv = (const float*)d_in[11];
  p.diff_lambda = (const float*)d_in[12]; p.diff_subln = (const float*)d_in[13]; p.conv_w = (const float*)d_in[14]; p.conv_b = (const float*)d_in[15];
  p.lru_wa = (const float*)d_in[16]; p.lru_ba = (const float*)d_in[17]; p.lru_wx = (const float*)d_in[18]; p.lru_bx = (const float*)d_in[19];
  p.lru_lambda = (const float*)d_in[20]; p.gqa_q_norm = (const float*)d_in[21]; p.gqa_k_norm = (const float*)d_in[22]; p.w_out = (const float*)d_in[23];
  p.final_norm = (const float*)d_in[24];
  p.out = (float*)d_out; p.ws = (char*)d_ws;
  hipMemsetAsync((char*)d_ws + OFF_CTR, 0, 256, stream);
  void* args[] = {&p};
  hipError_t e = hipLaunchCooperativeKernel((void*)hymba_fwd, dim3(grid_blocks), dim3(512), args, 0, stream);
  if (e != hipSuccess) fprintf(stderr, "cooperative launch failed: %s (grid %d)\n", hipGetErrorString(e), grid_blocks);
}
```

```cpp
#include <hip/hip_runtime.h>
#include <hip/hip_cooperative_groups.h>
#include <cstdio>
#include <cstdint>
namespace cg = cooperative_groups;

typedef unsigned short bf16_t;
using bf16x8 = __attribute__((ext_vector_type(8))) short;
using f32x16 = __attribute__((ext_vector_type(16))) float;
typedef __bf16 bf16x2_t __attribute__((ext_vector_type(2)));
typedef float f32x2_t __attribute__((ext_vector_type(2)));
using u32x4 = __attribute__((ext_vector_type(4))) unsigned;
using u32x2 = __attribute__((ext_vector_type(2))) unsigned;
#define DI __device__ __forceinline__
#define MFMA(a, b, c) __builtin_amdgcn_mfma_f32_32x32x16_bf16((a), (b), (c), 0, 0, 0)

constexpr int T_TOK = 98304, T_P = 65536, DM = 1024, ZS = 2944, NIN = 2912;
constexpr int ZC_QB = 0, ZC_KB = 256, ZC_VB = 512, ZC_GB = 768, ZC_XC = 1024, ZC_GC = 1280, ZC_QD = 1536,
              ZC_KD = 1792, ZC_VD = 1920, ZC_GD = 2048, ZC_GA = 2304, ZC_QA = 2560, ZC_KVA = 2752, ZC_KRA = 2880;
constexpr float LOG2E = 1.4426950408889634f;
constexpr float EPSN = 1e-6f;

constexpr size_t OFF_H = 0;
constexpr size_t SZ_H = (size_t)T_TOK * 1024 * 2;
constexpr size_t OFF_QA = OFF_H;
constexpr size_t OFF_KA = OFF_H + (size_t)T_TOK * 384 * 2;
constexpr size_t OFF_VTA = OFF_H + (size_t)T_TOK * 768 * 2;
constexpr size_t OFF_Z = OFF_H + SZ_H;
constexpr size_t OFF_VTB = OFF_Z + (size_t)T_TOK * ZS * 2;
constexpr size_t OFF_VTD = OFF_VTB + (size_t)T_TOK * 256 * 2;
constexpr size_t OFF_HFB = OFF_VTD + (size_t)T_TOK * 128 * 2;
constexpr size_t OFF_WIN = OFF_HFB + (size_t)T_TOK * 512 * 2;
constexpr size_t OFF_WOUT = OFF_WIN + (size_t)2 * 3072 * 1024 * 2;
constexpr size_t OFF_WUQ = OFF_WOUT + (size_t)2 * 1024 * 1280 * 2;
constexpr size_t OFF_WUKV = OFF_WUQ + (size_t)2 * 512 * 192 * 2;
constexpr size_t OFF_WLRU = OFF_WUKV + (size_t)2 * 512 * 128 * 2;
constexpr size_t OFF_MOD = OFF_WLRU + (size_t)2 * 2 * 2 * 4 * 64 * 64 * 2;
constexpr size_t OFF_TABM = OFF_MOD + (size_t)2 * 32 * 3072 * 4;
constexpr size_t OFF_TABP = OFF_TABM + (size_t)4096 * 16 * 8;
constexpr size_t OFF_TABX = OFF_TABP + (size_t)4096 * 4 * 8;
constexpr size_t OFF_LAM = OFF_TABX + (size_t)64 * 16 * 8;
constexpr size_t OFF_CTR = OFF_LAM + 256;
constexpr size_t OFF_RSS = OFF_CTR + 256;
constexpr size_t WS_NEED = OFF_RSS + (size_t)T_TOK * 8 * 4;

struct Params {
  const float* xin0; const float* xin1; const float* c0; const float* c1;
  const float *ada_w, *ada_b, *norm_g, *w_in, *mla_q_norm, *mla_w_uq, *mla_kv_norm, *mla_w_ukv,
      *diff_lambda, *diff_subln, *conv_w, *conv_b, *lru_wa, *lru_ba, *lru_wx, *lru_bx, *lru_lambda,
      *gqa_q_norm, *gqa_k_norm, *w_out, *final_norm;
  float* out;
  char* ws;
};

DI unsigned pack2(float a, float b) { f32x2_t v = {a, b}; bf16x2_t o = __builtin_convertvector(v, bf16x2_t); return __builtin_bit_cast(unsigned, o); }
DI bf16_t f2bf(float a) { return (bf16_t)(pack2(a, 0.f) & 0xffffu); }
DI float bf2f(bf16_t v) { return __uint_as_float(((unsigned)v) << 16); }
DI float bflo(unsigned u) { return __uint_as_float(u << 16); }
DI float bfhi(unsigned u) { return __uint_as_float(u & 0xffff0000u); }
DI int opaque_tid() { int t = threadIdx.x; asm volatile("" : "+v"(t)); return t; }
DI int crow(int i, int h) { return (i & 3) + 8 * (i >> 2) + 4 * h; }
DI int seq_start(int seq) { return seq < 16 ? (seq << 12) : T_P + ((seq - 16) << 11); }
DI int seq_len(int seq) { return seq < 16 ? 4096 : 2048; }
DI void tok2seq(int t, int& seq, int& s) { if (t < T_P) { seq = t >> 12; s = t & 4095; } else { int u = t - T_P; seq = 16 + (u >> 11); s = u & 2047; } }
DI float silu_f(float x) { return x / (1.f + __expf(-x)); }
DI float sigmoid_f(float x) { return 1.f / (1.f + __expf(-x)); }
DI float xhalf_max(float v) { unsigned u = __float_as_uint(v); auto rr = __builtin_amdgcn_permlane32_swap(u, u, false, false); return fmaxf(__uint_as_float(rr[0]), __uint_as_float(rr[1])); }
DI float xhalf_sum(float v) { unsigned u = __float_as_uint(v); auto rr = __builtin_amdgcn_permlane32_swap(u, u, false, false); return __uint_as_float(rr[0]) + __uint_as_float(rr[1]); }
DI void grid_barrier(unsigned* ctr, unsigned target) {
  __syncthreads();
  if (threadIdx.x == 0) {
    __threadfence();
    atomicAdd(ctr, 1u);
    while (__hip_atomic_load(ctr, __ATOMIC_RELAXED, __HIP_MEMORY_SCOPE_AGENT) < target) __builtin_amdgcn_s_sleep(4);
    __threadfence();
  }
  __syncthreads();
}
DI float wave_sum(float v) {
  v += __shfl_xor(v, 32); v += __shfl_xor(v, 16); v += __shfl_xor(v, 8); v += __shfl_xor(v, 4); v += __shfl_xor(v, 2); v += __shfl_xor(v, 1);
  return v;
}

constexpr int G_LDP = 72;
constexpr int G_STAGE = 512 * G_LDP;
template <class ASrc, class Epi>
DI void gemm_tile(ASrc asrc, const bf16_t* __restrict__ Bt, int ldb, int nk, int m0, int n0, Epi epi, bf16_t* lds) {
  const int tid = opaque_tid(), lane = tid & 63, w = tid >> 6, r = lane & 31, h = lane >> 5;
  const int wm = w >> 2, wn = w & 3;
  f32x16 acc[4][2];
#pragma unroll
  for (int mi = 0; mi < 4; ++mi)
#pragma unroll
    for (int ni = 0; ni < 2; ++ni)
#pragma unroll
      for (int i = 0; i < 16; ++i) acc[mi][ni][i] = 0.f;
  u32x4 ra[4], rb[4];
  const int lrow = tid >> 3, lch = tid & 7;
  auto gload = [&](int kt) {
    const bf16_t* ab; int as; asrc(kt, ab, as);
#pragma unroll
    for (int i = 0; i < 4; ++i) ra[i] = *(const u32x4*)(ab + (size_t)(m0 + lrow + 64 * i) * as + lch * 8);
#pragma unroll
    for (int i = 0; i < 4; ++i) rb[i] = *(const u32x4*)(Bt + (size_t)(n0 + lrow + 64 * i) * ldb + kt * 64 + lch * 8);
  };
  auto lstore = [&](int buf) {
    bf16_t* As = lds + buf * G_STAGE; bf16_t* Bs = As + 256 * G_LDP;
#pragma unroll
    for (int i = 0; i < 4; ++i) *(u32x4*)(As + (lrow + 64 * i) * G_LDP + lch * 8) = ra[i];
#pragma unroll
    for (int i = 0; i < 4; ++i) *(u32x4*)(Bs + (lrow + 64 * i) * G_LDP + lch * 8) = rb[i];
  };
  __syncthreads();
  gload(0);
  lstore(0);
  gload(1);
  for (int t = 0; t < nk; ++t) {
    __syncthreads();
    if (t + 1 < nk) lstore((t + 1) & 1);
    if (t + 2 < nk) gload(t + 2);
    const bf16_t* As = lds + (t & 1) * G_STAGE; const bf16_t* Bs = As + 256 * G_LDP;
#pragma unroll
    for (int ks = 0; ks < 4; ++ks) {
      bf16x8 a[4], b[2];
#pragma unroll
      for (int mi = 0; mi < 4; ++mi) a[mi] = *(const bf16x8*)(As + (wm * 128 + mi * 32 + r) * G_LDP + ks * 16 + 8 * h);
#pragma unroll
      for (int ni = 0; ni < 2; ++ni) b[ni] = *(const bf16x8*)(Bs + (wn * 64 + ni * 32 + r) * G_LDP + ks * 16 + 8 * h);
#pragma unroll
      for (int mi = 0; mi < 4; ++mi)
#pragma unroll
        for (int ni = 0; ni < 2; ++ni) acc[mi][ni] = MFMA(a[mi], b[ni], acc[mi][ni]);
    }
  }
#pragma unroll
  for (int mi = 0; mi < 4; ++mi)
#pragma unroll
    for (int ni = 0; ni < 2; ++ni) epi(m0 + wm * 128 + mi * 32, n0 + wn * 64 + ni * 32, acc[mi][ni]);
}

template <class ACol, class TileFn, class Epi>
DI void gemm_stream(const bf16_t* __restrict__ Abase, int as, ACol acol, const bf16_t* __restrict__ Bt, int ldb, int nk, TileFn tile_fn, Epi epi, bf16_t* lds) {
  const int tid = opaque_tid(), lane = tid & 63, w = tid >> 6, r = lane & 31, h = lane >> 5;
  const int wm = w >> 2, wn = w & 3;
  u32x4 ra[4], rb[4];
  const int lrow = tid >> 3, lch = tid & 7;
  const bf16_t* ap; const bf16_t* bp;
  auto gload = [&](int kt) {
    const int ac = acol(kt);
#pragma unroll
    for (int i = 0; i < 4; ++i) ra[i] = *(const u32x4*)(ap + (size_t)(64 * i) * as + ac);
#pragma unroll
    for (int i = 0; i < 4; ++i) rb[i] = *(const u32x4*)(bp + (size_t)(64 * i) * ldb + kt * 64);
  };
  auto lstore = [&](int buf) {
    bf16_t* As = lds + buf * G_STAGE; bf16_t* Bs = As + 256 * G_LDP;
#pragma unroll
    for (int i = 0; i < 4; ++i) *(u32x4*)(As + (lrow + 64 * i) * G_LDP + lch * 8) = ra[i];
#pragma unroll
    for (int i = 0; i < 4; ++i) *(u32x4*)(Bs + (lrow + 64 * i) * G_LDP + lch * 8) = rb[i];
  };
  int q = blockIdx.x >> 3; const int qstep = gridDim.x >> 3;
  int m0, n0;
  if (!tile_fn(q, m0, n0)) return;
  ap = Abase + (size_t)(m0 + lrow) * as + lch * 8; bp = Bt + (size_t)(n0 + lrow) * ldb + lch * 8;
  gload(0);
  while (true) {
    f32x16 acc[4][2];
#pragma unroll
    for (int mi = 0; mi < 4; ++mi)
#pragma unroll
      for (int ni = 0; ni < 2; ++ni)
#pragma unroll
        for (int i = 0; i < 16; ++i) acc[mi][ni][i] = 0.f;
    __syncthreads();
    lstore(0);
    gload(1);
    for (int t = 0; t < nk; ++t) {
      __syncthreads();
      const bf16_t* As = lds + (t & 1) * G_STAGE; const bf16_t* Bs = As + 256 * G_LDP;
      bf16_t* Asn = lds + ((t + 1) & 1) * G_STAGE; bf16_t* Bsn = Asn + 256 * G_LDP;
      const int ac2 = (t + 2 < nk) ? acol(t + 2) : 0;
#pragma unroll
      for (int ks = 0; ks < 4; ++ks) {
        bf16x8 a[4], b[2];
#pragma unroll
        for (int mi = 0; mi < 4; ++mi) a[mi] = *(const bf16x8*)(As + (wm * 128 + mi * 32 + r) * G_LDP + ks * 16 + 8 * h);
#pragma unroll
        for (int ni = 0; ni < 2; ++ni) b[ni] = *(const bf16x8*)(Bs + (wn * 64 + ni * 32 + r) * G_LDP + ks * 16 + 8 * h);
        __builtin_amdgcn_sched_barrier(0);
#pragma unroll
        for (int mi = 0; mi < 4; ++mi)
#pragma unroll
          for (int ni = 0; ni < 2; ++ni) acc[mi][ni] = MFMA(a[mi], b[ni], acc[mi][ni]);
        if (t + 1 < nk) {
          *(u32x4*)(Asn + (lrow + 64 * ks) * G_LDP + lch * 8) = ra[ks];
          *(u32x4*)(Bsn + (lrow + 64 * ks) * G_LDP + lch * 8) = rb[ks];
        }
        if (t + 2 < nk) {
          ra[ks] = *(const u32x4*)(ap + (size_t)(64 * ks) * as + ac2);
          rb[ks] = *(const u32x4*)(bp + (size_t)(64 * ks) * ldb + (t + 2) * 64);
        }
      }
    }
    q += qstep;
    int m1, n1;
    const bool v1 = tile_fn(q, m1, n1);
    if (v1) { ap = Abase + (size_t)(m1 + lrow) * as + lch * 8; bp = Bt + (size_t)(n1 + lrow) * ldb + lch * 8; gload(0); }
#pragma unroll
    for (int mi = 0; mi < 4; ++mi) epi(m0 + wm * 128 + mi * 32, n0 + wn * 64, acc[mi][0], acc[mi][1]);
    if (!v1) break;
    m0 = m1; n0 = n1;
  }
}

DI bool xcd_tile(int q, int n_sub, int n_mt, int& mt, int& sub) {
  const int x = blockIdx.x & 7;
  const int mloc = q / n_sub; sub = q - mloc * n_sub;
  mt = mloc * 8 + x;
  return mt < n_mt;
}

template <class SrcFn>
DI void transpose64(SrcFn src, bf16_t* dst, int dld, int k0, int n0, float* tile) {
  const int tid = opaque_tid();
  __syncthreads();
  {
    const int nn = tid & 63, kq = tid >> 6;
#pragma unroll 4
    for (int i = 0; i < 8; ++i) { int kk = kq + 8 * i; tile[kk * 65 + nn] = src(k0 + kk, n0 + nn); }
  }
  __syncthreads();
  {
    const int kk2 = (tid & 31) * 2, nq = tid >> 5;
#pragma unroll 4
    for (int i = 0; i < 4; ++i) {
      int nn2 = nq + 16 * i;
      *(unsigned*)(dst + (size_t)(n0 + nn2) * dld + k0 + kk2) = pack2(tile[kk2 * 65 + nn2], tile[(kk2 + 1) * 65 + nn2]);
    }
  }
}

DI int win_perm(int n) {
  if (n < 2304) return n + 608;
  if (n < 2560) return n - 2304 + 352;
  if (n < 2752) return n - 2560;
  if (n < 2880) return n - 2752 + 192;
  if (n < 2912) return n - 2880 + 320;
  return -1;
}

DI void mod_item(const Params& p, int l, int nc, float* lds) {
  float* sc = lds;
  float* red = lds + 8192;
  const int tid = opaque_tid(), col = tid & 63, kq = tid >> 6;
  const int n = nc * 64 + col;
  float acc[32];
#pragma unroll
  for (int i = 0; i < 32; ++i) acc[i] = 0.f;
  const float* W = p.ada_w + (size_t)l * 1024 * 3072;
  for (int st = 0; st < 4; ++st) {
    __syncthreads();
    for (int e = 0; e < 16; ++e) {
      int idx = e * 512 + tid; int seq = idx >> 8, kk = idx & 255;
      const float* cp = seq < 16 ? p.c0 + seq * 1024 : p.c1 + (seq - 16) * 1024;
      sc[kk * 32 + seq] = silu_f(cp[st * 256 + kk]);
    }
    __syncthreads();
    for (int kk0 = 0; kk0 < 32; kk0 += 8) {
      float wv[8];
#pragma unroll
      for (int u = 0; u < 8; ++u) wv[u] = W[(size_t)(st * 256 + kq * 32 + kk0 + u) * 3072 + n];
#pragma unroll
      for (int u = 0; u < 8; ++u) {
        const float4* s4 = (const float4*)(sc + (kq * 32 + kk0 + u) * 32);
#pragma unroll
        for (int j = 0; j < 8; ++j) { float4 v = s4[j]; acc[4 * j] += v.x * wv[u]; acc[4 * j + 1] += v.y * wv[u]; acc[4 * j + 2] += v.z * wv[u]; acc[4 * j + 3] += v.w * wv[u]; }
      }
    }
  }
  __syncthreads();
#pragma unroll
  for (int i = 0; i < 32; ++i) red[(kq * 32 + i) * 64 + col] = acc[i];
  __syncthreads();
  float* modp = (float*)(p.ws + OFF_MOD) + (size_t)l * 32 * 3072;
  for (int e = 0; e < 4; ++e) {
    int seq = kq * 4 + e;
    float v = 0.f;
#pragma unroll
    for (int g = 0; g < 8; ++g) v += red[(g * 32 + seq) * 64 + col];
    modp[seq * 3072 + n] = v + p.ada_b[l * 3072 + n];
  }
  __syncthreads();
}

DI void phase0a(const Params& p, float* lds) {
  const int tid = opaque_tid();
  bf16_t* wt_in = (bf16_t*)(p.ws + OFF_WIN);
  bf16_t* wt_out = (bf16_t*)(p.ws + OFF_WOUT);
  bf16_t* wt_uq = (bf16_t*)(p.ws + OFF_WUQ);
  bf16_t* wt_ukv = (bf16_t*)(p.ws + OFF_WUKV);
  bf16_t* wlru = (bf16_t*)(p.ws + OFF_WLRU);
  constexpr int N_MOD = 96, N_WIN = 2 * 48 * 16, N_WOUT = 2 * 16 * 16, N_WUQ = 2 * 8 * 3, N_WUKV = 2 * 8 * 2, N_LRU = 32, N_TAB = 162;
  constexpr int N_ALL = N_MOD + N_WIN + N_WOUT + N_WUQ + N_WUKV + N_LRU + N_TAB + 1;
  for (int it = blockIdx.x; it < N_ALL; it += gridDim.x) {
    int j = it;
    if (j < N_MOD) { mod_item(p, j / 48, j % 48, lds); continue; }
    j -= N_MOD;
    if (j < N_WIN) {
      int l = j / (48 * 16), rem = j % (48 * 16), nt = rem / 16, kt = rem % 16;
      const float* src = p.w_in + (size_t)l * 1024 * NIN;
      transpose64([&](int k, int n) { int on = win_perm(n); return on >= 0 ? src[(size_t)k * NIN + on] : 0.f; },
                  wt_in + (size_t)l * 3072 * 1024, 1024, kt * 64, nt * 64, lds);
      continue;
    }
    j -= N_WIN;
    if (j < N_WOUT) {
      int l = j / (16 * 16), rem = j % (16 * 16), nt = rem / 16, kt = rem % 16;
      const float* src = p.w_out + (size_t)l * 1024 * 1024;
      transpose64([&](int k, int n) { return src[(size_t)k * 1024 + n]; },
                  wt_out + (size_t)l * 1024 * 1024, 1024, kt * 64, nt * 64, lds);
      continue;
    }
    j -= N_WOUT;
    if (j < N_WUQ) {
      int l = j / 24, rem = j % 24, nt = rem / 3, kt = rem % 3;
      const float* src = p.mla_w_uq + (size_t)l * 192 * 384;
      const float* gq = p.mla_q_norm + l * 192;
      transpose64([&](int k, int n) { return n < 384 ? src[(size_t)k * 384 + n] * gq[k] : 0.f; }, wt_uq + (size_t)l * 512 * 192, 192, kt * 64, nt * 64, lds);
      continue;
    }
    j -= N_WUQ;
    if (j < N_WUKV) {
      int l = j / 16, rem = j % 16, nt = rem / 2, kt = rem % 2;
      const float* src = p.mla_w_ukv + (size_t)l * 128 * 512;
      const float* gk = p.mla_kv_norm + l * 128;
      transpose64([&](int k, int n) { return src[(size_t)k * 512 + n] * gk[k]; }, wt_ukv + (size_t)l * 512 * 128, 128, kt * 64, nt * 64, lds);
      continue;
    }
    j -= N_WUKV;
    if (j < N_LRU) {
      int hh = j & 3, mat = (j >> 2) & 1, d = (j >> 3) & 1, l = j >> 4;
      const float* src = (mat ? p.lru_wx : p.lru_wa) + (size_t)((l * 2 + d) * 4 + hh) * 4096;
      transpose64([&](int k, int n) { return src[k * 64 + n]; }, wlru + (size_t)j * 4096, 64, 0, 0, lds);
      continue;
    }
    j -= N_LRU;
    if (j < N_TAB) {
      int e = j * 512 + tid;
      float2* tm = (float2*)(p.ws + OFF_TABM); float2* tp = (float2*)(p.ws + OFF_TABP); float2* tx = (float2*)(p.ws + OFF_TABX);
      if (e < 65536) { int pos = e >> 4, f = e & 15; float inv = powf(10000.f, -(float)f / 16.f); float a = (float)pos * inv; tm[e] = make_float2(cosf(a), sinf(a)); }
      else if (e < 65536 + 16384) { int q = e - 65536; int pos = q >> 2, f = q & 3; float inv = powf(500000.f, -(float)f / 4.f); float a = (float)pos * inv; tp[q] = make_float2(cosf(a), sinf(a)); }
      else if (e < 65536 + 16384 + 1024) { int q = e - 65536 - 16384; int pos = q >> 4, f = q & 15; float inv = powf(10000.f, -(float)f / 16.f); float a = (float)pos * inv; tx[q] = make_float2(cosf(a), sinf(a)); }
      continue;
    }
    if (tid < 2) {
      int l = tid; const float* lf = p.diff_lambda + l * 128;
      float s1 = 0.f, s2 = 0.f;
      for (int i = 0; i < 32; ++i) { s1 += lf[i] * lf[32 + i]; s2 += lf[64 + i] * lf[96 + i]; }
      float lam_init = 0.8f - 0.6f * expf(-0.3f * (float)l);
      ((float*)(p.ws + OFF_LAM))[l] = expf(s1) - expf(s2) + lam_init;
    }
  }
}

DI void phase_norm(const Params& p, int l, int mode, bool from_input) {
  using f32x4 = __attribute__((ext_vector_type(4))) float;
  const int tid = opaque_tid(), lane = tid & 63, w = tid >> 6;
  bf16_t* hbuf = (bf16_t*)(p.ws + OFF_H);
  const float* modp = (const float*)(p.ws + OFF_MOD) + (size_t)l * 32 * 3072;
  const float* g = mode == 0 ? p.norm_g + l * 1024 : p.final_norm;
  for (int it = blockIdx.x; it < T_TOK / 32; it += gridDim.x) {
    const int t0 = it * 32 + w * 4;
    const float* xr0 = from_input ? (t0 < T_P ? p.xin0 + (size_t)t0 * 1024 : p.xin1 + (size_t)(t0 - T_P) * 1024) : p.out + (size_t)t0 * 1024;
    f32x4 v[4][4];
#pragma unroll
    for (int rr = 0; rr < 4; ++rr)
#pragma unroll
      for (int j = 0; j < 4; ++j) v[rr][j] = *(const f32x4*)(xr0 + rr * 1024 + j * 256 + lane * 4);
    f32x4 gs[4], sh4[4];
    {
      int seq, s; tok2seq(t0, seq, s);
      const float* sh = modp + seq * 3072; const float* scl = sh + 1024;
#pragma unroll
      for (int j = 0; j < 4; ++j) {
        const int k = j * 256 + lane * 4;
        f32x4 gg = *(const f32x4*)(g + k);
        if (mode == 0) { f32x4 s4 = *(const f32x4*)(scl + k); gs[j] = gg * (1.f + s4); sh4[j] = *(const f32x4*)(sh + k); }
        else { gs[j] = gg; sh4[j] = gg * 0.f; }
      }
    }
#pragma unroll
    for (int rr = 0; rr < 4; ++rr) {
      float ss = 0.f;
#pragma unroll
      for (int j = 0; j < 4; ++j) ss += v[rr][j].x * v[rr][j].x + v[rr][j].y * v[rr][j].y + v[rr][j].z * v[rr][j].z + v[rr][j].w * v[rr][j].w;
      ss = wave_sum(ss);
      const float rstd = rsqrtf(ss * (1.f / 1024.f) + EPSN);
      const int t = t0 + rr;
#pragma unroll
      for (int j = 0; j < 4; ++j) {
        const int k = j * 256 + lane * 4;
        f32x4 o = v[rr][j] * rstd * gs[j] + sh4[j];
        if (mode == 0) {
          u32x2 ou = {pack2(o.x, o.y), pack2(o.z, o.w)};
          *(u32x2*)(hbuf + (size_t)t * 1024 + k) = ou;
        } else {
          *(f32x4*)(p.out + (size_t)t * 1024 + k) = o;
        }
      }
    }
  }
}

DI void phase_inproj(const Params& p, int l, bf16_t* lds) {
  const bf16_t* hbuf = (const bf16_t*)(p.ws + OFF_H);
  const bf16_t* wt = (const bf16_t*)(p.ws + OFF_WIN) + (size_t)l * 3072 * 1024;
  bf16_t* z = (bf16_t*)(p.ws + OFF_Z);
  bf16_t* vtb = (bf16_t*)(p.ws + OFF_VTB);
  bf16_t* vtd = (bf16_t*)(p.ws + OFF_VTD);
  float* rss = (float*)(p.ws + OFF_RSS);
  const float2* tm = (const float2*)(p.ws + OFF_TABM); const float2* tp = (const float2*)(p.ws + OFF_TABP); const float2* tx = (const float2*)(p.ws + OFF_TABX);
  const float SCB = 0.17677669529663687f * LOG2E;
  const float SCD = 0.125f * LOG2E;
  constexpr int NT = 12, MT = T_TOK / 256;
  {
    gemm_stream(hbuf, 1024, [&](int kt) { return kt * 64; }, wt, 1024, 16,
              [&](int q, int& tm0, int& tn0) { int mt, nt; const bool v = xcd_tile(q, NT, MT, mt, nt); nt = (nt + (mt >> 3)) % NT; tm0 = mt * 256; tn0 = nt * 256; return v; },
              [&](int m0, int n64, const f32x16& acc0, const f32x16& acc1) {
                const int lane = opaque_tid() & 63, r = lane & 31, h = lane >> 5;
                int seq, s0; tok2seq(m0, seq, s0);
                const int S = seq_len(seq), st = seq_start(seq);
                if (n64 >= ZC_QD && n64 < ZC_VD) {
                  const bool isq = n64 < ZC_KD;
                  const float* gn = (isq ? p.gqa_q_norm : p.gqa_k_norm) + l * 64;
                  const float g0 = gn[r], g1 = gn[32 + r];
                  const float scl = isq ? SCD : 1.f;
#pragma unroll
                  for (int i = 0; i < 16; ++i) {
                    float ss = acc0[i] * acc0[i] + acc1[i] * acc1[i];
                    ss += __shfl_xor(ss, 1); ss += __shfl_xor(ss, 2); ss += __shfl_xor(ss, 4); ss += __shfl_xor(ss, 8); ss += __shfl_xor(ss, 16);
                    const float rstd = rsqrtf(ss * (1.f / 64.f) + EPSN);
                    const int sp = s0 + crow(i, h);
                    const float x0 = acc0[i] * rstd * g0, x1 = acc1[i] * rstd * g1;
                    const float p0 = __shfl_xor(x0, 16), p1 = __shfl_xor(x1, 16);
                    const float2 c0 = tx[(sp >> 6) * 16 + (r & 15)], c1 = tx[(sp & 63) * 16 + (r & 15)];
                    const float o0 = (r < 16 ? x0 * c0.x - p0 * c0.y : x0 * c0.x + p0 * c0.y) * scl;
                    const float o1 = (r < 16 ? x1 * c1.x - p1 * c1.y : x1 * c1.x + p1 * c1.y) * scl;
                    bf16_t* zr = z + (size_t)(m0 + crow(i, h)) * ZS + n64 + r;
                    zr[0] = f2bf(o0); zr[32] = f2bf(o1);
                  }
                  return;
                }
                if (n64 >= ZC_QA && n64 < ZC_KRA) {
                  float* rs = rss + (size_t)(m0 + 4 * h) * 8 + ((n64 - ZC_QA) >> 6);
#pragma unroll
                  for (int i = 0; i < 16; ++i) {
                    float ss = acc0[i] * acc0[i] + acc1[i] * acc1[i];
                    ss += __shfl_xor(ss, 1); ss += __shfl_xor(ss, 2); ss += __shfl_xor(ss, 4); ss += __shfl_xor(ss, 8); ss += __shfl_xor(ss, 16);
                    if (r == 0) rs[((i & 3) + 8 * (i >> 2)) * 8] = ss;
                  }
                }
#pragma unroll
                for (int ni = 0; ni < 2; ++ni) {
                  const f32x16& acc = ni == 0 ? acc0 : acc1;
                  const int n0 = n64 + ni * 32;
                  const int n = n0 + r;
                  if (n0 >= ZC_VB && n0 < ZC_GB) {
                    bf16_t* base = vtb + (size_t)st * 256 + (size_t)(n - ZC_VB) * S + s0;
#pragma unroll
                    for (int g4 = 0; g4 < 4; ++g4)
                      *(uint2*)(base + 8 * g4 + 4 * h) = make_uint2(pack2(acc[4 * g4], acc[4 * g4 + 1]), pack2(acc[4 * g4 + 2], acc[4 * g4 + 3]));
                  } else if (n0 >= ZC_VD && n0 < ZC_GD) {
                    bf16_t* base = vtd + (size_t)st * 128 + (size_t)(n - ZC_VD) * S + s0;
#pragma unroll
                    for (int g4 = 0; g4 < 4; ++g4)
                      *(uint2*)(base + 8 * g4 + 4 * h) = make_uint2(pack2(acc[4 * g4], acc[4 * g4 + 1]), pack2(acc[4 * g4 + 2], acc[4 * g4 + 3]));
                  } else if (n0 < ZC_VB) {
                    const float scl = n0 < ZC_KB ? SCB : 1.f;
#pragma unroll
                    for (int i = 0; i < 16; ++i) {
                      const float x = acc[i];
                      const float pr = __shfl_xor(x, 4);
                      const float2 cs = tp[(s0 + crow(i, h)) * 4 + (r & 3)];
                      const float o = r < 4 ? x * cs.x - pr * cs.y : (r < 8 ? x * cs.x + pr * cs.y : x);
                      z[(size_t)(m0 + crow(i, h)) * ZS + n] = f2bf(o * scl);
                    }
                  } else if (n0 == ZC_KRA) {
#pragma unroll
                    for (int i = 0; i < 16; ++i) {
                      const float x = acc[i];
                      const float pr = __shfl_xor(x, 16);
                      const float2 cs = tm[(s0 + crow(i, h)) * 16 + (r & 15)];
                      z[(size_t)(m0 + crow(i, h)) * ZS + n] = f2bf(r < 16 ? x * cs.x - pr * cs.y : x * cs.x + pr * cs.y);
                    }
                  } else if (n0 < NIN) {
#pragma unroll
                    for (int i = 0; i < 16; ++i) z[(size_t)(m0 + crow(i, h)) * ZS + n] = f2bf(acc[i]);
                  }
                }
              },
              lds);
  }
}

DI void phase_mla_up(const Params& p, int l, bf16_t* lds) {
  const bf16_t* z = (const bf16_t*)(p.ws + OFF_Z);
  bf16_t* QA = (bf16_t*)(p.ws + OFF_QA);
  bf16_t* KA = (bf16_t*)(p.ws + OFF_KA);
  bf16_t* VTA = (bf16_t*)(p.ws + OFF_VTA);
  const bf16_t* wuq = (const bf16_t*)(p.ws + OFF_WUQ) + (size_t)l * 512 * 192;
  const bf16_t* wukv = (const bf16_t*)(p.ws + OFF_WUKV) + (size_t)l * 512 * 128;
  const float2* tm = (const float2*)(p.ws + OFF_TABM);
  const float* rss = (const float*)(p.ws + OFF_RSS);
  const int lane = opaque_tid() & 63, r = lane & 31, h = lane >> 5;
  const float SCA = 0.10206207261596577f * LOG2E;
  constexpr int MT = T_TOK / 256;
  for (int q = blockIdx.x >> 3;; q += gridDim.x >> 3) {
    int mt, sub;
    if (!xcd_tile(q, 4, MT, mt, sub)) break;
    sub = (sub + (mt >> 6)) & 3;
    if (sub < 2) {
      gemm_tile([&](int kt, const bf16_t*& ab, int& as) { ab = z + ZC_QA + kt * 64; as = ZS; }, wuq, 192, 3, mt * 256, sub * 256,
                [&](int m0, int n0, const f32x16& acc) {
                  if (n0 >= 384) return;
                  const int n = n0 + r;
                  const bool pe = ((n0 >> 5) % 3) == 2;
                  int seq, s0; tok2seq(m0, seq, s0);
#pragma unroll
                  for (int i = 0; i < 16; ++i) {
                    const float* rs = rss + (size_t)(m0 + crow(i, h)) * 8;
                    float x = acc[i] * rsqrtf((rs[0] + rs[1] + rs[2]) * (1.f / 192.f) + EPSN);
                    if (pe) {
                      float pr = __shfl_xor(x, 16);
                      float2 cs = tm[(s0 + crow(i, h)) * 16 + (r & 15)];
                      x = (r < 16) ? x * cs.x - pr * cs.y : x * cs.x + pr * cs.y;
                    }
                    QA[(size_t)(m0 + crow(i, h)) * 384 + n] = f2bf(x * SCA);
                  }
                },
                lds);
    } else {
      gemm_tile([&](int kt, const bf16_t*& ab, int& as) { ab = z + ZC_KVA + kt * 64; as = ZS; }, wukv, 128, 2, mt * 256, (sub - 2) * 256,
                [&](int m0, int n0, const f32x16& acc) {
                  const int hh = n0 >> 7;
                  const int nn = (n0 & 127) + r;
                  auto rstd_of = [&](int i) { const float* rs = rss + (size_t)(m0 + crow(i, h)) * 8; return rsqrtf((rs[3] + rs[4]) * (1.f / 128.f) + EPSN); };
                  if (nn < 64) {
#pragma unroll
                    for (int i = 0; i < 16; ++i) KA[(size_t)(m0 + crow(i, h)) * 384 + hh * 96 + nn] = f2bf(acc[i] * rstd_of(i));
                    if (nn >= 32) {
#pragma unroll
                      for (int i = 0; i < 16; ++i) KA[(size_t)(m0 + crow(i, h)) * 384 + hh * 96 + 64 + r] = z[(size_t)(m0 + crow(i, h)) * ZS + ZC_KRA + r];
                    }
                  } else {
                    int seq, s; tok2seq(m0, seq, s); const int S = seq_len(seq), st = seq_start(seq);
                    bf16_t* base = VTA + (size_t)st * 256 + (size_t)(hh * 64 + nn - 64) * S + s;
#pragma unroll
                    for (int g4 = 0; g4 < 4; ++g4)
                      *(uint2*)(base + 8 * g4 + 4 * h) = make_uint2(pack2(acc[4 * g4] * rstd_of(4 * g4), acc[4 * g4 + 1] * rstd_of(4 * g4 + 1)), pack2(acc[4 * g4 + 2] * rstd_of(4 * g4 + 2), acc[4 * g4 + 3] * rstd_of(4 * g4 + 3)));
                  }
                },
                lds);
    }
  }
}

template <int DK, int KW, bool DIFF>
DI void attn_item(const bf16_t* qp, int qstride, const bf16_t* kp, int kstride, const bf16_t* vt, bf16_t* op, int ostride, const bf16_t* gp,
                  int S, int start, int qt, bf16_t* lds, float lam, float post_scale, const float* subln) {
  constexpr int KWP = KW + 8;
  constexpr int KCH = KW / 8;
  constexpr int KLD = (64 * KCH + 511) / 512;
  constexpr int NKS = DK / 16;
  bf16_t* Ks = lds;
  bf16_t* Vs = lds + 2 * 64 * KWP;
  float* Xc = (float*)(lds + 2 * 64 * KWP + 2 * 64 * 72);
  const int tid = opaque_tid(), lane = tid & 63, w = tid >> 6, r = lane & 31, h = lane >> 5;
  const int sub = DIFF ? (w >> 2) : 0;
  const int rblk = DIFF ? (w & 3) : w;
  const int koff = DIFF ? sub * DK : 0;
  const int qrow = start + qt * (DIFF ? 128 : 256) + rblk * 32 + r;
  bf16x8 qf[NKS];
#pragma unroll
  for (int ks = 0; ks < NKS; ++ks) qf[ks] = *(const bf16x8*)(qp + (size_t)qrow * qstride + koff + ks * 16 + 8 * h);
  constexpr bool USE_NM = true;
  f32x16 O[2], NM;
  float lrun = 0.f, mref = 0.f;
#pragma unroll
  for (int e = 0; e < 16; ++e) { O[0][e] = 0.f; O[1][e] = 0.f; NM[e] = 0.f; }
  u32x4 kreg[KLD], vreg;
  const int vrow = tid >> 3, vch = tid & 7;
  const int nt = S / 64;
  auto gloadK = [&](int t) {
#pragma unroll
    for (int i = 0; i < KLD; ++i) { int q = tid + 512 * i; int row = q / KCH, c = q % KCH; if (q < 64 * KCH) kreg[i] = *(const u32x4*)(kp + (size_t)(start + t * 64 + row) * kstride + c * 8); }
  };
  auto gloadV = [&](int t) { vreg = *(const u32x4*)(vt + (size_t)vrow * S + t * 64 + vch * 8); };
  auto storeK = [&](int buf) {
    bf16_t* kbn = Ks + buf * 64 * KWP;
#pragma unroll
    for (int i = 0; i < KLD; ++i) { int q = tid + 512 * i; int row = q / KCH, c = q % KCH; if (q < 64 * KCH) *(u32x4*)(kbn + row * KWP + c * 8) = kreg[i]; }
  };
  auto storeV = [&](int buf) {
    bf16_t* vbn = Vs + buf * 64 * 72;
    u32x2 lo2 = {vreg.x, vreg.y}; u32x2 hi2 = {vreg.z, vreg.w};
    bf16_t* dst = vbn + vrow * 72 + (vch >> 1) * 16 + (vch & 1) * 4;
    *(u32x2*)dst = lo2; *(u32x2*)(dst + 8) = hi2;
  };
  __syncthreads();
  gloadK(0); gloadV(0); storeK(0); storeV(0);
  gloadK(1); storeK(1);
  __syncthreads();
  f32x16 sc[2];
#pragma unroll
  for (int kb2 = 0; kb2 < 2; ++kb2) {
    sc[kb2] = NM;
#pragma unroll
    for (int ks = 0; ks < NKS; ++ks) {
      bf16x8 a = *(const bf16x8*)(Ks + (kb2 * 32 + r) * KWP + koff + ks * 16 + 8 * h);
      sc[kb2] = MFMA(a, qf[ks], sc[kb2]);
    }
  }
  if (w >= 4) __builtin_amdgcn_s_setprio(1);
  for (int t = 0; t < nt; ++t) {
    if (t + 2 < nt) gloadK(t + 2);
    if (t + 1 < nt) gloadV(t + 1);
    const bf16_t* kbn = Ks + ((t + 1) & 1) * 64 * KWP; const bf16_t* vb = Vs + (t & 1) * 64 * 72;
    u32x4 vf[2][4];
#pragma unroll
    for (int dvb = 0; dvb < 2; ++dvb)
#pragma unroll
      for (int c4 = 0; c4 < 2; ++c4) {
        vf[dvb][c4] = *(const u32x4*)(vb + (dvb * 32 + r) * 72 + c4 * 16 + 8 * h);
      }
    __builtin_amdgcn_sched_barrier(0);
    unsigned u0 = __float_as_uint(sc[0][0]), u1 = __float_as_uint(sc[0][1]), u2 = __float_as_uint(sc[1][0]), u3 = __float_as_uint(sc[1][1]);
#pragma unroll
    for (int e = 2; e < 16; e += 2) {
      u0 = min(u0, min(__float_as_uint(sc[0][e]), __float_as_uint(sc[0][e + 1])));
      u1 = min(u1, min(__float_as_uint(sc[1][e]), __float_as_uint(sc[1][e + 1])));
    }
    u0 = min(min(u0, u1), min(u2, u3));
    {
      auto rr = __builtin_amdgcn_permlane32_swap(u0, u0, false, false);
      u0 = min((unsigned)rr[0], (unsigned)rr[1]);
    }
    const float REF_GAP = 8.f;
    const float rel = USE_NM ? 0.f : mref;
    const bool grow = (u0 < 0x80000000u) || (__uint_as_float(u0) - rel > -2.f);
    if (t == 0 || __any(grow)) {
      float m0 = fmaxf(sc[0][0], sc[0][1]), m1 = fmaxf(sc[0][2], sc[0][3]), m2 = fmaxf(sc[1][0], sc[1][1]), m3 = fmaxf(sc[1][2], sc[1][3]);
#pragma unroll
      for (int e = 4; e < 16; e += 4) {
        m0 = fmaxf(m0, fmaxf(sc[0][e], sc[0][e + 1])); m1 = fmaxf(m1, fmaxf(sc[0][e + 2], sc[0][e + 3]));
        m2 = fmaxf(m2, fmaxf(sc[1][e], sc[1][e + 1])); m3 = fmaxf(m3, fmaxf(sc[1][e + 2], sc[1][e + 3]));
      }
      const float mx = xhalf_max(fmaxf(fmaxf(m0, m1), fmaxf(m2, m3))) - rel;
      const float delta = (t == 0) ? mx + REF_GAP : fmaxf(mx + REF_GAP, 0.f);
      const float corr = __builtin_amdgcn_exp2f(-delta);
      lrun *= corr;
      mref += delta;
#pragma unroll
      for (int e = 0; e < 16; ++e) {
        if (USE_NM) { sc[0][e] -= delta; sc[1][e] -= delta; NM[e] -= delta; }
        O[0][e] *= corr; O[1][e] *= corr;
      }
    }
    float p0 = 0.f, p1 = 0.f, p2 = 0.f, p3 = 0.f;
    bf16x8 pf[4];
#pragma unroll
    for (int kb2 = 0; kb2 < 2; ++kb2)
#pragma unroll
      for (int s2 = 0; s2 < 2; ++s2) {
        float a[8];
#pragma unroll
        for (int e = 0; e < 8; ++e) a[e] = __builtin_amdgcn_exp2f(USE_NM ? sc[kb2][8 * s2 + e] : sc[kb2][8 * s2 + e] - mref);
        p0 += a[0] + a[4]; p1 += a[1] + a[5]; p2 += a[2] + a[6]; p3 += a[3] + a[7];
        u32x4 pu = {pack2(a[0], a[1]), pack2(a[2], a[3]), pack2(a[4], a[5]), pack2(a[6], a[7])};
        pf[kb2 * 2 + s2] = __builtin_bit_cast(bf16x8, pu);
      }
    lrun += (p0 + p1) + (p2 + p3);
    bf16x8 kf0[NKS], kf1[NKS];
#pragma unroll
    for (int ks = 0; ks < NKS; ++ks) kf0[ks] = *(const bf16x8*)(kbn + r * KWP + koff + ks * 16 + 8 * h);
    __builtin_amdgcn_sched_barrier(0);
#pragma unroll
    for (int c4 = 0; c4 < 2; ++c4)
#pragma unroll
      for (int dvb = 0; dvb < 2; ++dvb) O[dvb] = MFMA(__builtin_bit_cast(bf16x8, vf[dvb][c4]), pf[c4], O[dvb]);
#pragma unroll
    for (int dvb = 0; dvb < 2; ++dvb)
#pragma unroll
      for (int c4 = 2; c4 < 4; ++c4) {
        vf[dvb][c4] = *(const u32x4*)(vb + (dvb * 32 + r) * 72 + c4 * 16 + 8 * h);
      }
#pragma unroll
    for (int ks = 0; ks < NKS; ++ks) kf1[ks] = *(const bf16x8*)(kbn + (32 + r) * KWP + koff + ks * 16 + 8 * h);
    __builtin_amdgcn_sched_barrier(0);
    sc[0] = NM; sc[1] = NM;
#pragma unroll
    for (int ks = 0; ks < NKS; ++ks) sc[0] = MFMA(kf0[ks], qf[ks], sc[0]);
#pragma unroll
    for (int c4 = 2; c4 < 4; ++c4)
#pragma unroll
      for (int dvb = 0; dvb < 2; ++dvb) O[dvb] = MFMA(__builtin_bit_cast(bf16x8, vf[dvb][c4]), pf[c4], O[dvb]);
#pragma unroll
    for (int ks = 0; ks < NKS; ++ks) sc[1] = MFMA(kf1[ks], qf[ks], sc[1]);
    if (t + 2 < nt) storeK(t & 1);
    if (t + 1 < nt) storeV((t + 1) & 1);
    __syncthreads();
  }
  __builtin_amdgcn_s_setprio(0);
  const float lt = xhalf_sum(lrun);
  const float inv = 1.f / lt;
  if (DIFF) {
    if (sub == 1) {
#pragma unroll
      for (int dvb = 0; dvb < 2; ++dvb)
#pragma unroll
        for (int e = 0; e < 16; ++e) Xc[(rblk * 64 + dvb * 32 + crow(e, h)) * 32 + r] = O[dvb][e] * inv;
    }
    __syncthreads();
    if (sub == 0) {
      float ss = 0.f;
#pragma unroll
      for (int dvb = 0; dvb < 2; ++dvb)
#pragma unroll
        for (int e = 0; e < 16; ++e) { float v = O[dvb][e] * inv - lam * Xc[(rblk * 64 + dvb * 32 + crow(e, h)) * 32 + r]; O[dvb][e] = v; ss += v * v; }
      ss = xhalf_sum(ss);
      const float rstd = rsqrtf(ss * (1.f / 64.f) + EPSN) * post_scale;
#pragma unroll
      for (int dvb = 0; dvb < 2; ++dvb)
#pragma unroll
        for (int g4 = 0; g4 < 4; ++g4) {
          const int dv = dvb * 32 + 8 * g4 + 4 * h;
          u32x2 gu = *(const u32x2*)(gp + (size_t)qrow * ZS + dv);
          float g0 = silu_f(bflo(gu.x)), g1 = silu_f(bfhi(gu.x)), g2 = silu_f(bflo(gu.y)), g3 = silu_f(bfhi(gu.y));
          float o0 = O[dvb][4 * g4] * rstd * subln[dv] * g0, o1 = O[dvb][4 * g4 + 1] * rstd * subln[dv + 1] * g1;
          float o2 = O[dvb][4 * g4 + 2] * rstd * subln[dv + 2] * g2, o3 = O[dvb][4 * g4 + 3] * rstd * subln[dv + 3] * g3;
          u32x2 ou = {pack2(o0, o1), pack2(o2, o3)};
          *(u32x2*)(op + (size_t)qrow * ostride + dv) = ou;
        }
    }
  } else {
#pragma unroll
    for (int dvb = 0; dvb < 2; ++dvb)
#pragma unroll
      for (int g4 = 0; g4 < 4; ++g4) {
        const int dv = dvb * 32 + 8 * g4 + 4 * h;
        u32x2 gu = *(const u32x2*)(gp + (size_t)qrow * ZS + dv);
        float g0 = silu_f(bflo(gu.x)), g1 = silu_f(bfhi(gu.x)), g2 = silu_f(bflo(gu.y)), g3 = silu_f(bfhi(gu.y));
        float o0 = O[dvb][4 * g4] * inv * g0, o1 = O[dvb][4 * g4 + 1] * inv * g1;
        float o2 = O[dvb][4 * g4 + 2] * inv * g2, o3 = O[dvb][4 * g4 + 3] * inv * g3;
        u32x2 ou = {pack2(o0, o1), pack2(o2, o3)};
        *(u32x2*)(op + (size_t)qrow * ostride + dv) = ou;
      }
  }
}

DI void scan_item(const Params& p, int l, int seq, int hh, char* ldsraw0) {
  const int tid512 = opaque_tid();
  const int dir = tid512 >> 8;
  char* ldsraw = ldsraw0 + dir * 61440;
  bf16_t* Xs = (bf16_t*)ldsraw;
  float* Xf = (float*)(ldsraw + 9216);
  float* Aa = Xf + 4096;
  float* Bb = Aa + 4096;
  float* SegA = Bb + 4096;
  float* SegB = SegA + 256;
  float* carry = SegB + 256;
  const int tid = tid512 & 255, lane = tid & 63, w = tid >> 6, r = lane & 31, h = lane >> 5;
  const int mi = w >> 1, ni = w & 1;
  const int S = seq_len(seq), start = seq_start(seq);
  const bf16_t* z = (const bf16_t*)(p.ws + OFF_Z);
  bf16_t* zw = (bf16_t*)(p.ws + OFF_Z);
  bf16_t* hfb = (bf16_t*)(p.ws + OFF_HFB);
  const bf16_t* wl = (const bf16_t*)(p.ws + OFF_WLRU);
  bf16x8 wf[2][4];
#pragma unroll
  for (int mat = 0; mat < 2; ++mat)
#pragma unroll
    for (int ks = 0; ks < 4; ++ks)
      wf[mat][ks] = *(const bf16x8*)(wl + (size_t)((((l * 2 + dir) * 2 + mat) * 4 + hh) * 64 + ni * 32 + r) * 64 + ks * 16 + 8 * h);
  const int che = hh * 64 + ni * 32 + r;
  const float ba = p.lru_ba[(l * 2 + dir) * 256 + che], bx = p.lru_bx[(l * 2 + dir) * 256 + che];
  const float sp8 = 8.f * log1pf(expf(-p.lru_lambda[(l * 2 + dir) * 256 + che]));
  const int c = tid & 63, q = tid >> 6;
  const int chs = hh * 64 + c;
  const float cw0 = p.conv_w[(l * 4 + 0) * 256 + chs], cw1 = p.conv_w[(l * 4 + 1) * 256 + chs], cw2 = p.conv_w[(l * 4 + 2) * 256 + chs], cw3 = p.conv_w[(l * 4 + 3) * 256 + chs];
  const float cb = p.conv_b[l * 256 + chs];
  __syncthreads();
  if (tid < 128) carry[tid] = 0.f;
  const int ntile = S / 64;
  const bf16_t* zx = z + (size_t)start * ZS + ZC_XC + chs;
  const bf16_t* zg = z + (size_t)start * ZS + ZC_GC + chs;
  bf16_t xn[19];
  {
    const int sb = (dir ? S - 64 : 0) + q * 16 - 2;
#pragma unroll
    for (int e = 0; e < 19; ++e) { int sp = sb + e; xn[e] = (sp >= 0 && sp < S) ? zx[(size_t)sp * ZS] : (bf16_t)0; }
  }
  for (int tile = 0; tile < ntile; ++tile) {
    const int p0 = dir ? S - 64 * (tile + 1) : 64 * tile;
    float xv[19];
#pragma unroll
    for (int e = 0; e < 19; ++e) xv[e] = bf2f(xn[e]);
    if (tile + 1 < ntile) {
      const int sb = (dir ? S - 64 * (tile + 2) : 64 * (tile + 1)) + q * 16 - 2;
#pragma unroll
      for (int e = 0; e < 19; ++e) { int sp = sb + e; xn[e] = (sp >= 0 && sp < S) ? zx[(size_t)sp * ZS] : (bf16_t)0; }
    }
    const bool first = tile < (ntile >> 1);
    unsigned gp[16];
    if (!first) {
#pragma unroll
      for (int jj = 0; jj < 16; ++jj) {
        const int u = q * 16 + jj; const int tok = dir ? 63 - u : u;
        gp[jj] = (unsigned)zg[(size_t)(p0 + tok) * ZS] | ((unsigned)hfb[(size_t)(start + p0 + tok) * 512 + (1 - dir) * 256 + chs] << 16);
      }
    }
#pragma unroll
    for (int jj = 0; jj < 16; ++jj) {
      float xc = cb + cw0 * xv[jj] + cw1 * xv[jj + 1] + cw2 * xv[jj + 2] + cw3 * xv[jj + 3];
      Xs[(q * 16 + jj) * 72 + c] = f2bf(xc);
      Xf[(q * 16 + jj) * 64 + c] = xc;
    }
    __syncthreads();
    {
      f32x16 aR, aI;
#pragma unroll
      for (int e = 0; e < 16; ++e) { aR[e] = 0.f; aI[e] = 0.f; }
#pragma unroll
      for (int ks = 0; ks < 4; ++ks) {
        bf16x8 a = *(const bf16x8*)(Xs + (mi * 32 + r) * 72 + ks * 16 + 8 * h);
        aR = MFMA(a, wf[0][ks], aR);
        aI = MFMA(a, wf[1][ks], aI);
      }
#pragma unroll
      for (int i = 0; i < 16; ++i) {
        const int tok = mi * 32 + crow(i, h), ch = ni * 32 + r;
        const float rr = __builtin_amdgcn_rcpf(1.f + __expf(-(aR[i] + ba)));
        const float ii = __builtin_amdgcn_rcpf(1.f + __expf(-(aI[i] + bx)));
        const float xq = Xf[tok * 64 + ch];
        const float log_a = -sp8 * rr;
        const float a = __expf(log_a);
        const float x2 = 2.f * log_a;
        const float ser = -x2 * (1.f + x2 * (0.5f + x2 * (0.16666667f + x2 * 0.041666668f)));
        const float om = x2 > -0.1f ? ser : 1.f - __expf(x2);
        const float gx = __builtin_amdgcn_sqrtf(om) * (ii * xq);
        Aa[tok * 64 + ch] = a; Bb[tok * 64 + ch] = gx;
      }
    }
    __syncthreads();
    float Ac[16], Bc[16];
    {
      float A = 1.f, B = 0.f;
#pragma unroll
      for (int jj = 0; jj < 16; ++jj) {
        const int u = q * 16 + jj; const int tok = dir ? 63 - u : u;
        float a = Aa[tok * 64 + c], b = Bb[tok * 64 + c];
        B = a * B + b; A = A * a; Ac[jj] = A; Bc[jj] = B;
      }
      SegA[q * 64 + c] = A; SegB[q * 64 + c] = B;
    }
    __syncthreads();
    {
      float cin = carry[(tile & 1) * 64 + c];
      for (int qq = 0; qq < q; ++qq) cin = SegA[qq * 64 + c] * cin + SegB[qq * 64 + c];
#pragma unroll
      for (int jj = 0; jj < 16; ++jj) {
        const int u = q * 16 + jj; const int tok = dir ? 63 - u : u;
        float hv = Ac[jj] * cin + Bc[jj];
        const size_t trow = (size_t)(start + p0 + tok);
        if (first) hfb[trow * 512 + dir * 256 + chs] = f2bf(hv);
        else zw[trow * ZS + ZC_GC + chs] = f2bf((hv + bfhi(gp[jj])) * silu_f(bflo(gp[jj])));
        if (jj == 15 && q == 3) carry[((tile + 1) & 1) * 64 + c] = hv;
      }
    }
    __syncthreads();
  }
}

DI void phase_mix(const Params& p, int l, char* ldsraw) {
  __shared__ int s_item;
  const int tid = threadIdx.x;
  const int x = blockIdx.x & 7;
  int* ctr = (int*)(p.ws + OFF_CTR) + l * 8 + x;
  bf16_t* z = (bf16_t*)(p.ws + OFF_Z);
  bf16_t* QA = (bf16_t*)(p.ws + OFF_QA);
  bf16_t* KA = (bf16_t*)(p.ws + OFF_KA);
  const bf16_t* VTA = (const bf16_t*)(p.ws + OFF_VTA);
  const bf16_t* VTB = (const bf16_t*)(p.ws + OFF_VTB);
  const bf16_t* VTD = (const bf16_t*)(p.ws + OFF_VTD);
  const float lam = ((const float*)(p.ws + OFF_LAM))[l];
  const float lam_init = l == 0 ? 0.2f : 0.8f - 0.6f * 0.7408182206817179f;
  constexpr int N_ITEMS = 16 + 512 + 256;
  while (true) {
    __syncthreads();
    if (tid == 0) s_item = atomicAdd(ctr, 1);
    __syncthreads();
    int j = __builtin_amdgcn_readfirstlane(s_item);
    if (j >= N_ITEMS) break;
    if (j < 16) { const int id = j * 8 + x; scan_item(p, l, id >> 2, id & 3, ldsraw); continue; }
    j -= 16;
    int type, seq, head, qt;
    if (j < 512) {
      if (j < 256) { type = 1; const int gg = (j >> 5) * 8 + x; seq = gg >> 2; head = gg & 3; qt = j & 31; }
      else { type = j < 384 ? 2 : 0; const int jj = j & 127; const int gg = (jj >> 4) * 8 + x; seq = gg >> 2; head = gg & 3; qt = jj & 15; }
    } else {
      j -= 512;
      if (j < 128) { type = 1; const int gg = (j >> 4) * 8 + x; seq = 16 + (gg >> 2); head = gg & 3; qt = j & 15; }
      else { type = j < 192 ? 2 : 0; const int jj = j & 63; const int gg = (jj >> 3) * 8 + x; seq = 16 + (gg >> 2); head = gg & 3; qt = jj & 7; }
    }
    const int S = seq_len(seq), start = seq_start(seq);
    if (type == 0) {
      attn_item<96, 96, false>(QA + head * 96, 384, KA + head * 96, 384, VTA + (size_t)start * 256 + (size_t)head * 64 * S,
                               z + ZC_VB + head * 64, ZS, z + ZC_GA + head * 64, S, start, qt, (bf16_t*)ldsraw, 0.f, 0.f, nullptr);
    } else if (type == 1) {
      attn_item<32, 64, true>(z + ZC_QB + head * 64, ZS, z + ZC_KB + head * 64, ZS, VTB + (size_t)start * 256 + (size_t)head * 64 * S,
                              z + ZC_QB + head * 64, ZS, z + ZC_GB + head * 64, S, start, qt, (bf16_t*)ldsraw, lam, 1.f - lam_init, p.diff_subln + l * 64);
    } else {
      attn_item<64, 64, false>(z + ZC_QD + head * 64, ZS, z + ZC_KD + (head >> 1) * 64, ZS, VTD + (size_t)start * 128 + (size_t)(head >> 1) * 64 * S,
                               z + ZC_QD + head * 64, ZS, z + ZC_GD + head * 64, S, start, qt, (bf16_t*)ldsraw, 0.f, 0.f, nullptr);
    }
  }
}

DI void phase_outproj(const Params& p, int l, bf16_t* lds) {
  const bf16_t* z = (const bf16_t*)(p.ws + OFF_Z);
  const bf16_t* QA = (const bf16_t*)(p.ws + OFF_QA);
  const bf16_t* hfb = (const bf16_t*)(p.ws + OFF_HFB);
  const bf16_t* wt = (const bf16_t*)(p.ws + OFF_WOUT) + (size_t)l * 1024 * 1024;
  const float* modp = (const float*)(p.ws + OFF_MOD) + (size_t)l * 32 * 3072;
  const int lane = opaque_tid() & 63, r = lane & 31, h = lane >> 5;
  constexpr int NT = 4, MT = T_TOK / 256;
  {
    gemm_stream(z, ZS,
        [&](int kt) {
          const int grp = kt >> 2, sub = kt & 3;
          const int col = grp == 0 ? ZC_VB : (grp == 1 ? ZC_QB : (grp == 2 ? ZC_GC : ZC_QD));
          return col + sub * 64;
        },
        wt, 1024, 16,
        [&](int q, int& tm0, int& tn0) { int mt, nt; const bool v = xcd_tile(q, NT, MT, mt, nt); tm0 = mt * 256; tn0 = nt * 256; return v; },
        [&](int m0, int n64, const f32x16& acc0, const f32x16& acc1) {
         const int lane = opaque_tid() & 63, r = lane & 31, h = lane >> 5;
         const int n = n64 + r;
         int seq, s; tok2seq(m0, seq, s);
         const float gate0 = modp[seq * 3072 + 2048 + n], gate1 = modp[seq * 3072 + 2048 + n + 32];
         const float* xb = (l == 0) ? (m0 < T_P ? p.xin0 + (size_t)m0 * 1024 : p.xin1 + (size_t)(m0 - T_P) * 1024) : p.out + (size_t)m0 * 1024;
         xb += (size_t)(4 * h) * 1024 + n;
         float* ob = p.out + (size_t)(m0 + 4 * h) * 1024 + n;
         float x0[16], x1[16];
#pragma unroll
         for (int i = 0; i < 16; ++i) { const int ro = ((i & 3) + 8 * (i >> 2)) * 1024; x0[i] = xb[ro]; x1[i] = xb[ro + 32]; }
#pragma unroll
         for (int i = 0; i < 16; ++i) { const int ro = ((i & 3) + 8 * (i >> 2)) * 1024; ob[ro] = x0[i] + gate0 * acc0[i]; ob[ro + 32] = x1[i] + gate1 * acc1[i]; }
        },
        lds);
  }
}

__global__ void __launch_bounds__(512, 2) hymba_fwd(Params p) {
  cg::grid_group grid = cg::this_grid();
  unsigned* gbar = (unsigned*)(p.ws + OFF_CTR) + 48;
  const unsigned nblk = gridDim.x;
  unsigned gb_n = 0;
  __shared__ __attribute__((aligned(16))) char lds[147456];
  phase0a(p, (float*)lds);
  grid.sync();
  phase_norm(p, 0, 0, true);
  grid_barrier(gbar, nblk * (++gb_n));
#pragma unroll 1
  for (int l = 0; l < 2; ++l) {
    phase_inproj(p, l, (bf16_t*)lds);
    grid_barrier(gbar, nblk * (++gb_n));
    phase_mla_up(p, l, (bf16_t*)lds);
    grid_barrier(gbar, nblk * (++gb_n));
    phase_mix(p, l, lds);
    grid_barrier(gbar, nblk * (++gb_n));
    phase_outproj(p, l, (bf16_t*)lds);
    grid_barrier(gbar, nblk * (++gb_n));
    if (l == 0) { phase_norm(p, 1, 0, false); grid_barrier(gbar, nblk * (++gb_n)); }
    else phase_norm(p, 0, 1, false);
  }
}

extern "C" void kernel_launch(void* const* d_in, const int* in_sizes, int n_in, void* d_out, int out_size, void* d_ws, size_t ws_size, hipStream_t stream) {
  if (ws_size < WS_NEED) { fprintf(stderr, "workspace too small: %zu < %zu\n", ws_size, (size_t)WS_NEED); return; }
  static int grid_blocks = 0;
  if (!grid_blocks) {
    int dev = 0, cus = 0, per_cu = 0;
    hipGetDevice(&dev);
    hipDeviceGetAttribute(&cus, hipDeviceAttributeMultiprocessorCount, dev);
    hipOccupancyMaxActiveBlocksPerMultiprocessor(&per_cu, hymba_fwd, 512, 0);
    if (per_cu > 1) per_cu = 1;
    if (per_cu < 1) per_cu = 1;
    grid_blocks = (cus * per_cu) & ~7;
  }
  Params p{};
  p.xin0 = (const float*)d_in[0]; p.xin1 = (const float*)d_in[1]; p.c0 = (const float*)d_in[2]; p.c1 = (const float*)d_in[3];
  p.ada_w = (const float*)d_in[4]; p.ada_b = (const float*)d_in[5]; p.norm_g = (const float*)d_in[6]; p.w_in = (const float*)d_in[7];
  p.mla_q_norm = (const float*)d_in[8]; p.mla_w_uq = (const float*)d_in[9]; p.mla_kv_norm = (const float*)d_in[10]; p.mla_w_ukv = (const float*)d_in[11];
  p.diff_lambda = (const float*)d_in[12]; p.diff_subln = (const float*)d_in[13]; p.conv_w = (const float*)d_in[14]; p.conv_b = (const float*)d_in[15];
  p.lru_wa = (const float*)d_in[16]; p.lru_ba = (const float*)d_in[17]; p.lru_wx = (const float*)d_in[18]; p.lru_bx = (const float*)d_in[19];
  p.lru_lambda = (const float*)d_in[20]; p.gqa_q_norm = (const float*)d_in[21]; p.gqa_k_norm = (const float*)d_in[22]; p.w_out = (const float*)d_in[23];
  p.final_norm = (const float*)d_in[24];
  p.out = (float*)d_out; p.ws = (char*)d_ws;
  hipMemsetAsync((char*)d_ws + OFF_CTR, 0, 256, stream);
  void* args[] = {&p};
  hipError_t e = hipLaunchCooperativeKernel((void*)hymba_fwd, dim3(grid_blocks), dim3(512), args, 0, stream);
  if (e != hipSuccess) fprintf(stderr, "cooperative launch failed: %s (grid %d)\n", hipGetErrorString(e), grid_blocks);
}
```

```cpp
#include <hip/hip_runtime.h>
#include <hip/hip_cooperative_groups.h>
#include <cstdio>
#include <cstdint>
namespace cg = cooperative_groups;

typedef unsigned short bf16_t;
using bf16x8 = __attribute__((ext_vector_type(8))) short;
using f32x16 = __attribute__((ext_vector_type(16))) float;
typedef __bf16 bf16x2_t __attribute__((ext_vector_type(2)));
typedef float f32x2_t __attribute__((ext_vector_type(2)));
using u32x4 = __attribute__((ext_vector_type(4))) unsigned;
using u32x2 = __attribute__((ext_vector_type(2))) unsigned;
#define DI __device__ __forceinline__
#define MFMA(a, b, c) __builtin_amdgcn_mfma_f32_32x32x16_bf16((a), (b), (c), 0, 0, 0)

constexpr int T_TOK = 98304, T_P = 65536, DM = 1024, ZS = 2944, NIN = 2912;
constexpr int ZC_QB = 0, ZC_KB = 256, ZC_VB = 512, ZC_GB = 768, ZC_XC = 1024, ZC_GC = 1280, ZC_QD = 1536,
              ZC_KD = 1792, ZC_VD = 1920, ZC_GD = 2048, ZC_GA = 2304, ZC_QA = 2560, ZC_KVA = 2752, ZC_KRA = 2880;
constexpr float LOG2E = 1.4426950408889634f;
constexpr float EPSN = 1e-6f;

constexpr size_t OFF_H = 0;
constexpr size_t SZ_H = (size_t)T_TOK * 1024 * 2;
constexpr size_t OFF_QA = OFF_H;
constexpr size_t OFF_KA = OFF_H + (size_t)T_TOK * 384 * 2;
constexpr size_t OFF_VTA = OFF_H + (size_t)T_TOK * 768 * 2;
constexpr size_t OFF_Z = OFF_H + SZ_H;
constexpr size_t OFF_VTB = OFF_Z + (size_t)T_TOK * ZS * 2;
constexpr size_t OFF_VTD = OFF_VTB + (size_t)T_TOK * 256 * 2;
constexpr size_t OFF_HFB = OFF_VTD + (size_t)T_TOK * 128 * 2;
constexpr size_t OFF_WIN = OFF_HFB + (size_t)T_TOK * 512 * 2;
constexpr size_t OFF_WOUT = OFF_WIN + (size_t)2 * 3072 * 1024 * 2;
constexpr size_t OFF_WUQ = OFF_WOUT + (size_t)2 * 1024 * 1280 * 2;
constexpr size_t OFF_WUKV = OFF_WUQ + (size_t)2 * 512 * 192 * 2;
constexpr size_t OFF_WLRU = OFF_WUKV + (size_t)2 * 512 * 128 * 2;
constexpr size_t OFF_MOD = OFF_WLRU + (size_t)2 * 2 * 2 * 4 * 64 * 64 * 2;
constexpr size_t OFF_TABM = OFF_MOD + (size_t)2 * 32 * 3072 * 4;
constexpr size_t OFF_TABP = OFF_TABM + (size_t)4096 * 16 * 8;
constexpr size_t OFF_TABX = OFF_TABP + (size_t)4096 * 4 * 8;
constexpr size_t OFF_LAM = OFF_TABX + (size_t)64 * 16 * 8;
constexpr size_t OFF_CTR = OFF_LAM + 256;
constexpr size_t OFF_RSS = OFF_CTR + 256;
constexpr size_t WS_NEED = OFF_RSS + (size_t)T_TOK * 8 * 4;

struct Params {
  const float* xin0; const float* xin1; const float* c0; const float* c1;
  const float *ada_w, *ada_b, *norm_g, *w_in, *mla_q_norm, *mla_w_uq, *mla_kv_norm, *mla_w_ukv,
      *diff_lambda, *diff_subln, *conv_w, *conv_b, *lru_wa, *lru_ba, *lru_wx, *lru_bx, *lru_lambda,
      *gqa_q_norm, *gqa_k_norm, *w_out, *final_norm;
  float* out;
  char* ws;
};

DI unsigned pack2(float a, float b) { f32x2_t v = {a, b}; bf16x2_t o = __builtin_convertvector(v, bf16x2_t); return __builtin_bit_cast(unsigned, o); }
DI bf16_t f2bf(float a) { return (bf16_t)(pack2(a, 0.f) & 0xffffu); }
DI float bf2f(bf16_t v) { return __uint_as_float(((unsigned)v) << 16); }
DI float bflo(unsigned u) { return __uint_as_float(u << 16); }
DI float bfhi(unsigned u) { return __uint_as_float(u & 0xffff0000u); }
DI int opaque_tid() { int t = threadIdx.x; asm volatile("" : "+v"(t)); return t; }
DI int crow(int i, int h) { return (i & 3) + 8 * (i >> 2) + 4 * h; }
DI int seq_start(int seq) { return seq < 16 ? (seq << 12) : T_P + ((seq - 16) << 11); }
DI int seq_len(int seq) { return seq < 16 ? 4096 : 2048; }
DI void tok2seq(int t, int& seq, int& s) { if (t < T_P) { seq = t >> 12; s = t & 4095; } else { int u = t - T_P; seq = 16 + (u >> 11); s = u & 2047; } }
DI float silu_f(float x) { return x / (1.f + __expf(-x)); }
DI float sigmoid_f(float x) { return 1.f / (1.f + __expf(-x)); }
DI float xhalf_max(float v) { unsigned u = __float_as_uint(v); auto rr = __builtin_amdgcn_permlane32_swap(u, u, false, false); return fmaxf(__uint_as_float(rr[0]), __uint_as_float(rr[1])); }
DI float xhalf_sum(float v) { unsigned u = __float_as_uint(v); auto rr = __builtin_amdgcn_permlane32_swap(u, u, false, false); return __uint_as_float(rr[0]) + __uint_as_float(rr[1]); }
DI void grid_barrier(unsigned* ctr, unsigned target) {
  __syncthreads();
  if (threadIdx.x == 0) {
    __threadfence();
    atomicAdd(ctr, 1u);
    while (__hip_atomic_load(ctr, __ATOMIC_RELAXED, __HIP_MEMORY_SCOPE_AGENT) < target) __builtin_amdgcn_s_sleep(4);
    __threadfence();
  }
  __syncthreads();
}
DI float wave_sum(float v) {
  v += __shfl_xor(v, 32); v += __shfl_xor(v, 16); v += __shfl_xor(v, 8); v += __shfl_xor(v, 4); v += __shfl_xor(v, 2); v += __shfl_xor(v, 1);
  return v;
}

constexpr int G_LDP = 72;
constexpr int G_STAGE = 512 * G_LDP;
template <class ASrc, class Epi>
DI void gemm_tile(ASrc asrc, const bf16_t* __restrict__ Bt, int ldb, int nk, int m0, int n0, Epi epi, bf16_t* lds) {
  const int tid = opaque_tid(), lane = tid & 63, w = tid >> 6, r = lane & 31, h = lane >> 5;
  const int wm = w >> 2, wn = w & 3;
  f32x16 acc[4][2];
#pragma unroll
  for (int mi = 0; mi < 4; ++mi)
#pragma unroll
    for (int ni = 0; ni < 2; ++ni)
#pragma unroll
      for (int i = 0; i < 16; ++i) acc[mi][ni][i] = 0.f;
  u32x4 ra[4], rb[4];
  const int lrow = tid >> 3, lch = tid & 7;
  auto gload = [&](int kt) {
    const bf16_t* ab; int as; asrc(kt, ab, as);
#pragma unroll
    for (int i = 0; i < 4; ++i) ra[i] = *(const u32x4*)(ab + (size_t)(m0 + lrow + 64 * i) * as + lch * 8);
#pragma unroll
    for (int i = 0; i < 4; ++i) rb[i] = *(const u32x4*)(Bt + (size_t)(n0 + lrow + 64 * i) * ldb + kt * 64 + lch * 8);
  };
  auto lstore = [&](int buf) {
    bf16_t* As = lds + buf * G_STAGE; bf16_t* Bs = As + 256 * G_LDP;
#pragma unroll
    for (int i = 0; i < 4; ++i) *(u32x4*)(As + (lrow + 64 * i) * G_LDP + lch * 8) = ra[i];
#pragma unroll
    for (int i = 0; i < 4; ++i) *(u32x4*)(Bs + (lrow + 64 * i) * G_LDP + lch * 8) = rb[i];
  };
  __syncthreads();
  gload(0);
  lstore(0);
  gload(1);
  for (int t = 0; t < nk; ++t) {
    __syncthreads();
    if (t + 1 < nk) lstore((t + 1) & 1);
    if (t + 2 < nk) gload(t + 2);
    const bf16_t* As = lds + (t & 1) * G_STAGE; const bf16_t* Bs = As + 256 * G_LDP;
#pragma unroll
    for (int ks = 0; ks < 4; ++ks) {
      bf16x8 a[4], b[2];
#pragma unroll
      for (int mi = 0; mi < 4; ++mi) a[mi] = *(const bf16x8*)(As + (wm * 128 + mi * 32 + r) * G_LDP + ks * 16 + 8 * h);
#pragma unroll
      for (int ni = 0; ni < 2; ++ni) b[ni] = *(const bf16x8*)(Bs + (wn * 64 + ni * 32 + r) * G_LDP + ks * 16 + 8 * h);
#pragma unroll
      for (int mi = 0; mi < 4; ++mi)
#pragma unroll
        for (int ni = 0; ni < 2; ++ni) acc[mi][ni] = MFMA(a[mi], b[ni], acc[mi][ni]);
    }
  }
#pragma unroll
  for (int mi = 0; mi < 4; ++mi)
#pragma unroll
    for (int ni = 0; ni < 2; ++ni) epi(m0 + wm * 128 + mi * 32, n0 + wn * 64 + ni * 32, acc[mi][ni]);
}

template <class ACol, class TileFn, class Epi>
DI void gemm_stream(const bf16_t* __restrict__ Abase, int as, ACol acol, const bf16_t* __restrict__ Bt, int ldb, int nk, TileFn tile_fn, Epi epi, bf16_t* lds) {
  const int tid = opaque_tid(), lane = tid & 63, w = tid >> 6, r = lane & 31, h = lane >> 5;
  const int wm = w >> 2, wn = w & 3;
  u32x4 ra[4], rb[4];
  const int lrow = tid >> 3, lch = tid & 7;
  const bf16_t* ap; const bf16_t* bp;
  auto gload = [&](int kt) {
    const int ac = acol(kt);
#pragma unroll
    for (int i = 0; i < 4; ++i) ra[i] = *(const u32x4*)(ap + (size_t)(64 * i) * as + ac);
#pragma unroll
    for (int i = 0; i < 4; ++i) rb[i] = *(const u32x4*)(bp + (size_t)(64 * i) * ldb + kt * 64);
  };
  auto lstore = [&](int buf) {
    bf16_t* As = lds + buf * G_STAGE; bf16_t* Bs = As + 256 * G_LDP;
#pragma unroll
    for (int i = 0; i < 4; ++i) *(u32x4*)(As + (lrow + 64 * i) * G_LDP + lch * 8) = ra[i];
#pragma unroll
    for (int i = 0; i < 4; ++i) *(u32x4*)(Bs + (lrow + 64 * i) * G_LDP + lch * 8) = rb[i];
  };
  int q = blockIdx.x >> 3; const int qstep = gridDim.x >> 3;
  int m0, n0;
  if (!tile_fn(q, m0, n0)) return;
  ap = Abase + (size_t)(m0 + lrow) * as + lch * 8; bp = Bt + (size_t)(n0 + lrow) * ldb + lch * 8;
  gload(0);
  while (true) {
    f32x16 acc[4][2];
#pragma unroll
    for (int mi = 0; mi < 4; ++mi)
#pragma unroll
      for (int ni = 0; ni < 2; ++ni)
#pragma unroll
        for (int i = 0; i < 16; ++i) acc[mi][ni][i] = 0.f;
    __syncthreads();
    lstore(0);
    gload(1);
    for (int t = 0; t < nk; ++t) {
      __syncthreads();
      const bf16_t* As = lds + (t & 1) * G_STAGE; const bf16_t* Bs = As + 256 * G_LDP;
      bf16_t* Asn = lds + ((t + 1) & 1) * G_STAGE; bf16_t* Bsn = Asn + 256 * G_LDP;
      const int ac2 = (t + 2 < nk) ? acol(t + 2) : 0;
#pragma unroll
      for (int ks = 0; ks < 4; ++ks) {
        bf16x8 a[4], b[2];
#pragma unroll
        for (int mi = 0; mi < 4; ++mi) a[mi] = *(const bf16x8*)(As + (wm * 128 + mi * 32 + r) * G_LDP + ks * 16 + 8 * h);
#pragma unroll
        for (int ni = 0; ni < 2; ++ni) b[ni] = *(const bf16x8*)(Bs + (wn * 64 + ni * 32 + r) * G_LDP + ks * 16 + 8 * h);
        __builtin_amdgcn_sched_barrier(0);
#pragma unroll
        for (int mi = 0; mi < 4; ++mi)
#pragma unroll
          for (int ni = 0; ni < 2; ++ni) acc[mi][ni] = MFMA(a[mi], b[ni], acc[mi][ni]);
        if (t + 1 < nk) {
          *(u32x4*)(Asn + (lrow + 64 * ks) * G_LDP + lch * 8) = ra[ks];
          *(u32x4*)(Bsn + (lrow + 64 * ks) * G_LDP + lch * 8) = rb[ks];
        }
        if (t + 2 < nk) {
          ra[ks] = *(const u32x4*)(ap + (size_t)(64 * ks) * as + ac2);
          rb[ks] = *(const u32x4*)(bp + (size_t)(64 * ks) * ldb + (t + 2) * 64);
        }
      }
    }
    q += qstep;
    int m1, n1;
    const bool v1 = tile_fn(q, m1, n1);
    if (v1) { ap = Abase + (size_t)(m1 + lrow) * as + lch * 8; bp = Bt + (size_t)(n1 + lrow) * ldb + lch * 8; gload(0); }
#pragma unroll
    for (int mi = 0; mi < 4; ++mi) epi(m0 + wm * 128 + mi * 32, n0 + wn * 64, acc[mi][0], acc[mi][1]);
    if (!v1) break;
    m0 = m1; n0 = n1;
  }
}

DI bool xcd_tile(int q, int n_sub, int n_mt, int& mt, int& sub) {
  const int x = blockIdx.x & 7;
  const int mloc = q / n_sub; sub = q - mloc * n_sub;
  mt = mloc * 8 + x;
  return mt < n_mt;
}

template <class SrcFn>
DI void transpose64(SrcFn src, bf16_t* dst, int dld, int k0, int n0, float* tile) {
  const int tid = opaque_tid();
  __syncthreads();
  {
    const int nn = tid & 63, kq = tid >> 6;
#pragma unroll 4
    for (int i = 0; i < 8; ++i) { int kk = kq + 8 * i; tile[kk * 65 + nn] = src(k0 + kk, n0 + nn); }
  }
  __syncthreads();
  {
    const int kk2 = (tid & 31) * 2, nq = tid >> 5;
#pragma unroll 4
    for (int i = 0; i < 4; ++i) {
      int nn2 = nq + 16 * i;
      *(unsigned*)(dst + (size_t)(n0 + nn2) * dld + k0 + kk2) = pack2(tile[kk2 * 65 + nn2], tile[(kk2 + 1) * 65 + nn2]);
    }
  }
}

DI int win_perm(int n) {
  if (n < 2304) return n + 608;
  if (n < 2560) return n - 2304 + 352;
  if (n < 2752) return n - 2560;
  if (n < 2880) return n - 2752 + 192;
  if (n < 2912) return n - 2880 + 320;
  return -1;
}

DI void mod_item(const Params& p, int l, int nc, float* lds) {
  float* sc = lds;
  float* red = lds + 8192;
  const int tid = opaque_tid(), col = tid & 63, kq = tid >> 6;
  const int n = nc * 64 + col;
  float acc[32];
#pragma unroll
  for (int i = 0; i < 32; ++i) acc[i] = 0.f;
  const float* W = p.ada_w + (size_t)l * 1024 * 3072;
  for (int st = 0; st < 4; ++st) {
    __syncthreads();
    for (int e = 0; e < 16; ++e) {
      int idx = e * 512 + tid; int seq = idx >> 8, kk = idx & 255;
      const float* cp = seq < 16 ? p.c0 + seq * 1024 : p.c1 + (seq - 16) * 1024;
      sc[kk * 32 + seq] = silu_f(cp[st * 256 + kk]);
    }
    __syncthreads();
    for (int kk0 = 0; kk0 < 32; kk0 += 8) {
      float wv[8];
#pragma unroll
      for (int u = 0; u < 8; ++u) wv[u] = W[(size_t)(st * 256 + kq * 32 + kk0 + u) * 3072 + n];
#pragma unroll
      for (int u = 0; u < 8; ++u) {
        const float4* s4 = (const float4*)(sc + (kq * 32 + kk0 + u) * 32);
#pragma unroll
        for (int j = 0; j < 8; ++j) { float4 v = s4[j]; acc[4 * j] += v.x * wv[u]; acc[4 * j + 1] += v.y * wv[u]; acc[4 * j + 2] += v.z * wv[u]; acc[4 * j + 3] += v.w * wv[u]; }
      }
    }
  }
  __syncthreads();
#pragma unroll
  for (int i = 0; i < 32; ++i) red[(kq * 32 + i) * 64 + col] = acc[i];
  __syncthreads();
  float* modp = (float*)(p.ws + OFF_MOD) + (size_t)l * 32 * 3072;
  for (int e = 0; e < 4; ++e) {
    int seq = kq * 4 + e;
    float v = 0.f;
#pragma unroll
    for (int g = 0; g < 8; ++g) v += red[(g * 32 + seq) * 64 + col];
    modp[seq * 3072 + n] = v + p.ada_b[l * 3072 + n];
  }
  __syncthreads();
}

DI void phase0a(const Params& p, float* lds) {
  const int tid = opaque_tid();
  bf16_t* wt_in = (bf16_t*)(p.ws + OFF_WIN);
  bf16_t* wt_out = (bf16_t*)(p.ws + OFF_WOUT);
  bf16_t* wt_uq = (bf16_t*)(p.ws + OFF_WUQ);
  bf16_t* wt_ukv = (bf16_t*)(p.ws + OFF_WUKV);
  bf16_t* wlru = (bf16_t*)(p.ws + OFF_WLRU);
  constexpr int N_MOD = 96, N_WIN = 2 * 48 * 16, N_WOUT = 2 * 16 * 16, N_WUQ = 2 * 8 * 3, N_WUKV = 2 * 8 * 2, N_LRU = 32, N_TAB = 162;
  constexpr int N_ALL = N_MOD + N_WIN + N_WOUT + N_WUQ + N_WUKV + N_LRU + N_TAB + 1;
  for (int it = blockIdx.x; it < N_ALL; it += gridDim.x) {
    int j = it;
    if (j < N_MOD) { mod_item(p, j / 48, j % 48, lds); continue; }
    j -= N_MOD;
    if (j < N_WIN) {
      int l = j / (48 * 16), rem = j % (48 * 16), nt = rem / 16, kt = rem % 16;
      const float* src = p.w_in + (size_t)l * 1024 * NIN;
      transpose64([&](int k, int n) { int on = win_perm(n); return on >= 0 ? src[(size_t)k * NIN + on] : 0.f; },
                  wt_in + (size_t)l * 3072 * 1024, 1024, kt * 64, nt * 64, lds);
      continue;
    }
    j -= N_WIN;
    if (j < N_WOUT) {
      int l = j / (16 * 16), rem = j % (16 * 16), nt = rem / 16, kt = rem % 16;
      const float* src = p.w_out + (size_t)l * 1024 * 1024;
      transpose64([&](int k, int n) { return src[(size_t)k * 1024 + n]; },
                  wt_out + (size_t)l * 1024 * 1024, 1024, kt * 64, nt * 64, lds);
      continue;
    }
    j -= N_WOUT;
    if (j < N_WUQ) {
      int l = j / 24, rem = j % 24, nt = rem / 3, kt = rem % 3;
      const float* src = p.mla_w_uq + (size_t)l * 192 * 384;
      const float* gq = p.mla_q_norm + l * 192;
      transpose64([&](int k, int n) { return n < 384 ? src[(size_t)k * 384 + n] * gq[k] : 0.f; }, wt_uq + (size_t)l * 512 * 192, 192, kt * 64, nt * 64, lds);
      continue;
    }
    j -= N_WUQ;
    if (j < N_WUKV) {
      int l = j / 16, rem = j % 16, nt = rem / 2, kt = rem % 2;
      const float* src = p.mla_w_ukv + (size_t)l * 128 * 512;
      const float* gk = p.mla_kv_norm + l * 128;
      transpose64([&](int k, int n) { return src[(size_t)k * 512 + n] * gk[k]; }, wt_ukv + (size_t)l * 512 * 128, 128, kt * 64, nt * 64, lds);
      continue;
    }
    j -= N_WUKV;
    if (j < N_LRU) {
      int hh = j & 3, mat = (j >> 2) & 1, d = (j >> 3) & 1, l = j >> 4;
      const float* src = (mat ? p.lru_wx : p.lru_wa) + (size_t)((l * 2 + d) * 4 + hh) * 4096;
      transpose64([&](int k, int n) { return src[k * 64 + n]; }, wlru + (size_t)j * 4096, 64, 0, 0, lds);
      continue;
    }
    j -= N_LRU;
    if (j < N_TAB) {
      int e = j * 512 + tid;
      float2* tm = (float2*)(p.ws + OFF_TABM); float2* tp = (float2*)(p.ws + OFF_TABP); float2* tx = (float2*)(p.ws + OFF_TABX);
      if (e < 65536) { int pos = e >> 4, f = e & 15; float inv = powf(10000.f, -(float)f / 16.f); float a = (float)pos * inv; tm[e] = make_float2(cosf(a), sinf(a)); }
      else if (e < 65536 + 16384) { int q = e - 65536; int pos = q >> 2, f = q & 3; float inv = powf(500000.f, -(float)f / 4.f); float a = (float)pos * inv; tp[q] = make_float2(cosf(a), sinf(a)); }
      else if (e < 65536 + 16384 + 1024) { int q = e - 65536 - 16384; int pos = q >> 4, f = q & 15; float inv = powf(10000.f, -(float)f / 16.f); float a = (float)pos * inv; tx[q] = make_float2(cosf(a), sinf(a)); }
      continue;
    }
    if (tid < 2) {
      int l = tid; const float* lf = p.diff_lambda + l * 128;
      float s1 = 0.f, s2 = 0.f;
      for (int i = 0; i < 32; ++i) { s1 += lf[i] * lf[32 + i]; s2 += lf[64 + i] * lf[96 + i]; }
      float lam_init = 0.8f - 0.6f * expf(-0.3f * (float)l);
      ((float*)(p.ws + OFF_LAM))[l] = expf(s1) - expf(s2) + lam_init;
    }
  }
}

DI void phase_norm(const Params& p, int l, int mode, bool from_input) {
  using f32x4 = __attribute__((ext_vector_type(4))) float;
  const int tid = opaque_tid(), lane = tid & 63, w = tid >> 6;
  bf16_t* hbuf = (bf16_t*)(p.ws + OFF_H);
  const float* modp = (const float*)(p.ws + OFF_MOD) + (size_t)l * 32 * 3072;
  const float* g = mode == 0 ? p.norm_g + l * 1024 : p.final_norm;
  for (int it = blockIdx.x; it < T_TOK / 32; it += gridDim.x) {
    const int t0 = it * 32 + w * 4;
    const float* xr0 = from_input ? (t0 < T_P ? p.xin0 + (size_t)t0 * 1024 : p.xin1 + (size_t)(t0 - T_P) * 1024) : p.out + (size_t)t0 * 1024;
    f32x4 v[4][4];
#pragma unroll
    for (int rr = 0; rr < 4; ++rr)
#pragma unroll
      for (int j = 0; j < 4; ++j) v[rr][j] = *(const f32x4*)(xr0 + rr * 1024 + j * 256 + lane * 4);
    f32x4 gs[4], sh4[4];
    {
      int seq, s; tok2seq(t0, seq, s);
      const float* sh = modp + seq * 3072; const float* scl = sh + 1024;
#pragma unroll
      for (int j = 0; j < 4; ++j) {
        const int k = j * 256 + lane * 4;
        f32x4 gg = *(const f32x4*)(g + k);
        if (mode == 0) { f32x4 s4 = *(const f32x4*)(scl + k); gs[j] = gg * (1.f + s4); sh4[j] = *(const f32x4*)(sh + k); }
        else { gs[j] = gg; sh4[j] = gg * 0.f; }
      }
    }
#pragma unroll
    for (int rr = 0; rr < 4; ++rr) {
      float ss = 0.f;
#pragma unroll
      for (int j = 0; j < 4; ++j) ss += v[rr][j].x * v[rr][j].x + v[rr][j].y * v[rr][j].y + v[rr][j].z * v[rr][j].z + v[rr][j].w * v[rr][j].w;
      ss = wave_sum(ss);
      const float rstd = rsqrtf(ss * (1.f / 1024.f) + EPSN);
      const int t = t0 + rr;
#pragma unroll
      for (int j = 0; j < 4; ++j) {
        const int k = j * 256 + lane * 4;
        f32x4 o = v[rr][j] * rstd * gs[j] + sh4[j];
        if (mode == 0) {
          u32x2 ou = {pack2(o.x, o.y), pack2(o.z, o.w)};
          *(u32x2*)(hbuf + (size_t)t * 1024 + k) = ou;
        } else {
          *(f32x4*)(p.out + (size_t)t * 1024 + k) = o;
        }
      }
    }
  }
}

DI void phase_inproj(const Params& p, int l, bf16_t* lds) {
  const bf16_t* hbuf = (const bf16_t*)(p.ws + OFF_H);
  const bf16_t* wt = (const bf16_t*)(p.ws + OFF_WIN) + (size_t)l * 3072 * 1024;
  bf16_t* z = (bf16_t*)(p.ws + OFF_Z);
  bf16_t* vtb = (bf16_t*)(p.ws + OFF_VTB);
  bf16_t* vtd = (bf16_t*)(p.ws + OFF_VTD);
  float* rss = (float*)(p.ws + OFF_RSS);
  const float2* tm = (const float2*)(p.ws + OFF_TABM); const float2* tp = (const float2*)(p.ws + OFF_TABP); const float2* tx = (const float2*)(p.ws + OFF_TABX);
  const float SCB = 0.17677669529663687f * LOG2E;
  const float SCD = 0.125f * LOG2E;
  constexpr int NT = 12, MT = T_TOK / 256;
  {
    gemm_stream(hbuf, 1024, [&](int kt) { return kt * 64; }, wt, 1024, 16,
              [&](int q, int& tm0, int& tn0) { int mt, nt; const bool v = xcd_tile(q, NT, MT, mt, nt); nt = (nt + (mt >> 3)) % NT; tm0 = mt * 256; tn0 = nt * 256; return v; },
              [&](int m0, int n64, const f32x16& acc0, const f32x16& acc1) {
                const int lane = opaque_tid() & 63, r = lane & 31, h = lane >> 5;
                int seq, s0; tok2seq(m0, seq, s0);
                const int S = seq_len(seq), st = seq_start(seq);
                if (n64 >= ZC_QD && n64 < ZC_VD) {
                  const bool isq = n64 < ZC_KD;
                  const float* gn = (isq ? p.gqa_q_norm : p.gqa_k_norm) + l * 64;
                  const float g0 = gn[r], g1 = gn[32 + r];
                  const float scl = isq ? SCD : 1.f;
#pragma unroll
                  for (int i = 0; i < 16; ++i) {
                    float ss = acc0[i] * acc0[i] + acc1[i] * acc1[i];
                    ss += __shfl_xor(ss, 1); ss += __shfl_xor(ss, 2); ss += __shfl_xor(ss, 4); ss += __shfl_xor(ss, 8); ss += __shfl_xor(ss, 16);
                    const float rstd = rsqrtf(ss * (1.f / 64.f) + EPSN);
                    const int sp = s0 + crow(i, h);
                    const float x0 = acc0[i] * rstd * g0, x1 = acc1[i] * rstd * g1;
                    const float p0 = __shfl_xor(x0, 16), p1 = __shfl_xor(x1, 16);
                    const float2 c0 = tx[(sp >> 6) * 16 + (r & 15)], c1 = tx[(sp & 63) * 16 + (r & 15)];
                    const float o0 = (r < 16 ? x0 * c0.x - p0 * c0.y : x0 * c0.x + p0 * c0.y) * scl;
                    const float o1 = (r < 16 ? x1 * c1.x - p1 * c1.y : x1 * c1.x + p1 * c1.y) * scl;
                    bf16_t* zr = z + (size_t)(m0 + crow(i, h)) * ZS + n64 + r;
                    zr[0] = f2bf(o0); zr[32] = f2bf(o1);
                  }
                  return;
                }
                if (n64 >= ZC_QA && n64 < ZC_KRA) {
                  float* rs = rss + (size_t)(m0 + 4 * h) * 8 + ((n64 - ZC_QA) >> 6);
#pragma unroll
                  for (int i = 0; i < 16; ++i) {
                    float ss = acc0[i] * acc0[i] + acc1[i] * acc1[i];
                    ss += __shfl_xor(ss, 1); ss += __shfl_xor(ss, 2); ss += __shfl_xor(ss, 4); ss += __shfl_xor(ss, 8); ss += __shfl_xor(ss, 16);
                    if (r == 0) rs[((i & 3) + 8 * (i >> 2)) * 8] = ss;
                  }
                }
#pragma unroll
                for (int ni = 0; ni < 2; ++ni) {
                  const f32x16& acc = ni == 0 ? acc0 : acc1;
                  const int n0 = n64 + ni * 32;
                  const int n = n0 + r;
                  if (n0 >= ZC_VB && n0 < ZC_GB) {
                    bf16_t* base = vtb + (size_t)st * 256 + (size_t)(n - ZC_VB) * S + s0;
#pragma unroll
                    for (int g4 = 0; g4 < 4; ++g4)
                      *(uint2*)(base + 8 * g4 + 4 * h) = make_uint2(pack2(acc[4 * g4], acc[4 * g4 + 1]), pack2(acc[4 * g4 + 2], acc[4 * g4 + 3]));
                  } else if (n0 >= ZC_VD && n0 < ZC_GD) {
                    bf16_t* base = vtd + (size_t)st * 128 + (size_t)(n - ZC_VD) * S + s0;
#pragma unroll
                    for (int g4 = 0; g4 < 4; ++g4)
                      *(uint2*)(base + 8 * g4 + 4 * h) = make_uint2(pack2(acc[4 * g4], acc[4 * g4 + 1]), pack2(acc[4 * g4 + 2], acc[4 * g4 + 3]));
                  } else if (n0 < ZC_VB) {
                    const float scl = n0 < ZC_KB ? SCB : 1.f;
#pragma unroll
                    for (int i = 0; i < 16; ++i) {
                      const float x = acc[i];
                      const float pr = __shfl_xor(x, 4);
                      const float2 cs = tp[(s0 + crow(i, h)) * 4 + (r & 3)];
                      const float o = r < 4 ? x * cs.x - pr * cs.y : (r < 8 ? x * cs.x + pr * cs.y : x);
                      z[(size_t)(m0 + crow(i, h)) * ZS + n] = f2bf(o * scl);
                    }
                  } else if (n0 == ZC_KRA) {
#pragma unroll
                    for (int i = 0; i < 16; ++i) {
                      const float x = acc[i];
                      const float pr = __shfl_xor(x, 16);
                      const float2 cs = tm[(s0 + crow(i, h)) * 16 + (r & 15)];
                      z[(size_t)(m0 + crow(i, h)) * ZS + n] = f2bf(r < 16 ? x * cs.x - pr * cs.y : x * cs.x + pr * cs.y);
                    }
                  } else if (n0 < NIN) {
#pragma unroll
                    for (int i = 0; i < 16; ++i) z[(size_t)(m0 + crow(i, h)) * ZS + n] = f2bf(acc[i]);
                  }
                }
              },
              lds);
  }
}

DI void phase_mla_up(const Params& p, int l, bf16_t* lds) {
  const bf16_t* z = (const bf16_t*)(p.ws + OFF_Z);
  bf16_t* QA = (bf16_t*)(p.ws + OFF_QA);
  bf16_t* KA = (bf16_t*)(p.ws + OFF_KA);
  bf16_t* VTA = (bf16_t*)(p.ws + OFF_VTA);
  const bf16_t* wuq = (const bf16_t*)(p.ws + OFF_WUQ) + (size_t)l * 512 * 192;
  const bf16_t* wukv = (const bf16_t*)(p.ws + OFF_WUKV) + (size_t)l * 512 * 128;
  const float2* tm = (const float2*)(p.ws + OFF_TABM);
  const float* rss = (const float*)(p.ws + OFF_RSS);
  const int lane = opaque_tid() & 63, r = lane & 31, h = lane >> 5;
  const float SCA = 0.10206207261596577f * LOG2E;
  constexpr int MT = T_TOK / 256;
  for (int q = blockIdx.x >> 3;; q += gridDim.x >> 3) {
    int mt, sub;
    if (!xcd_tile(q, 4, MT, mt, sub)) break;
    sub = (sub + (mt >> 6)) & 3;
    if (sub < 2) {
      gemm_tile([&](int kt, const bf16_t*& ab, int& as) { ab = z + ZC_QA + kt * 64; as = ZS; }, wuq, 192, 3, mt * 256, sub * 256,
                [&](int m0, int n0, const f32x16& acc) {
                  if (n0 >= 384) return;
                  const int n = n0 + r;
                  const bool pe = ((n0 >> 5) % 3) == 2;
                  int seq, s0; tok2seq(m0, seq, s0);
#pragma unroll
                  for (int i = 0; i < 16; ++i) {
                    const float* rs = rss + (size_t)(m0 + crow(i, h)) * 8;
                    float x = acc[i] * rsqrtf((rs[0] + rs[1] + rs[2]) * (1.f / 192.f) + EPSN);
                    if (pe) {
                      float pr = __shfl_xor(x, 16);
                      float2 cs = tm[(s0 + crow(i, h)) * 16 + (r & 15)];
                      x = (r < 16) ? x * cs.x - pr * cs.y : x * cs.x + pr * cs.y;
                    }
                    QA[(size_t)(m0 + crow(i, h)) * 384 + n] = f2bf(x * SCA);
                  }
                },
                lds);
    } else {
      gemm_tile([&](int kt, const bf16_t*& ab, int& as) { ab = z + ZC_KVA + kt * 64; as = ZS; }, wukv, 128, 2, mt * 256, (sub - 2) * 256,
                [&](int m0, int n0, const f32x16& acc) {
                  const int hh = n0 >> 7;
                  const int nn = (n0 & 127) + r;
                  auto rstd_of = [&](int i) { const float* rs = rss + (size_t)(m0 + crow(i, h)) * 8; return rsqrtf((rs[3] + rs[4]) * (1.f / 128.f) + EPSN); };
                  if (nn < 64) {
#pragma unroll
                    for (int i = 0; i < 16; ++i) KA[(size_t)(m0 + crow(i, h)) * 384 + hh * 96 + nn] = f2bf(acc[i] * rstd_of(i));
                    if (nn >= 32) {
                      bf16_t kpe[16];
#pragma unroll
                      for (int i = 0; i < 16; ++i) kpe[i] = z[(size_t)(m0 + crow(i, h)) * ZS + ZC_KRA + r];
#pragma unroll
                      for (int i = 0; i < 16; ++i) KA[(size_t)(m0 + crow(i, h)) * 384 + hh * 96 + 64 + r] = kpe[i];
                    }
                  } else {
                    int seq, s; tok2seq(m0, seq, s); const int S = seq_len(seq), st = seq_start(seq);
                    bf16_t* base = VTA + (size_t)st * 256 + (size_t)(hh * 64 + nn - 64) * S + s;
#pragma unroll
                    for (int g4 = 0; g4 < 4; ++g4)
                      *(uint2*)(base + 8 * g4 + 4 * h) = make_uint2(pack2(acc[4 * g4] * rstd_of(4 * g4), acc[4 * g4 + 1] * rstd_of(4 * g4 + 1)), pack2(acc[4 * g4 + 2] * rstd_of(4 * g4 + 2), acc[4 * g4 + 3] * rstd_of(4 * g4 + 3)));
                  }
                },
                lds);
    }
  }
}

template <int DK, int KW, bool DIFF>
DI void attn_item(const bf16_t* qp, int qstride, const bf16_t* kp, int kstride, const bf16_t* vt, bf16_t* op, int ostride, const bf16_t* gp,
                  int S, int start, int qt, bf16_t* lds, float lam, float post_scale, const float* subln) {
  constexpr int KWP = KW + 8;
  constexpr int KCH = KW / 8;
  constexpr int KLD = (64 * KCH + 511) / 512;
  constexpr int NKS = DK / 16;
  bf16_t* Ks = lds;
  bf16_t* Vs = lds + 2 * 64 * KWP;
  float* Xc = (float*)(lds + 2 * 64 * KWP + 2 * 64 * 72);
  const int tid = opaque_tid(), lane = tid & 63, w = tid >> 6, r = lane & 31, h = lane >> 5;
  const int sub = DIFF ? (w >> 2) : 0;
  const int rblk = DIFF ? (w & 3) : w;
  const int koff = DIFF ? sub * DK : 0;
  const int qrow = start + qt * (DIFF ? 128 : 256) + rblk * 32 + r;
  bf16x8 qf[NKS];
#pragma unroll
  for (int ks = 0; ks < NKS; ++ks) qf[ks] = *(const bf16x8*)(qp + (size_t)qrow * qstride + koff + ks * 16 + 8 * h);
  constexpr bool USE_NM = true;
  f32x16 O[2], NM;
  float lrun = 0.f, mref = 0.f;
#pragma unroll
  for (int e = 0; e < 16; ++e) { O[0][e] = 0.f; O[1][e] = 0.f; NM[e] = 0.f; }
  u32x4 kreg[KLD], vreg;
  const int vrow = tid >> 3, vch = tid & 7;
  const int nt = S / 64;
  auto gloadK = [&](int t) {
#pragma unroll
    for (int i = 0; i < KLD; ++i) { int q = tid + 512 * i; int row = q / KCH, c = q % KCH; if (q < 64 * KCH) kreg[i] = *(const u32x4*)(kp + (size_t)(start + t * 64 + row) * kstride + c * 8); }
  };
  auto gloadV = [&](int t) { vreg = *(const u32x4*)(vt + (size_t)vrow * S + t * 64 + vch * 8); };
  auto storeK = [&](int buf) {
    bf16_t* kbn = Ks + buf * 64 * KWP;
#pragma unroll
    for (int i = 0; i < KLD; ++i) { int q = tid + 512 * i; int row = q / KCH, c = q % KCH; if (q < 64 * KCH) *(u32x4*)(kbn + row * KWP + c * 8) = kreg[i]; }
  };
  auto storeV = [&](int buf) {
    bf16_t* vbn = Vs + buf * 64 * 72;
    u32x2 lo2 = {vreg.x, vreg.y}; u32x2 hi2 = {vreg.z, vreg.w};
    bf16_t* dst = vbn + vrow * 72 + (vch >> 1) * 16 + (vch & 1) * 4;
    *(u32x2*)dst = lo2; *(u32x2*)(dst + 8) = hi2;
  };
  __syncthreads();
  gloadK(0); gloadV(0); storeK(0); storeV(0);
  gloadK(1); storeK(1);
  __syncthreads();
  f32x16 sc[2];
#pragma unroll
  for (int kb2 = 0; kb2 < 2; ++kb2) {
    sc[kb2] = NM;
#pragma unroll
    for (int ks = 0; ks < NKS; ++ks) {
      bf16x8 a = *(const bf16x8*)(Ks + (kb2 * 32 + r) * KWP + koff + ks * 16 + 8 * h);
      sc[kb2] = MFMA(a, qf[ks], sc[kb2]);
    }
  }
  if (w >= 4) __builtin_amdgcn_s_setprio(1);
  for (int t = 0; t < nt; ++t) {
    if (t + 2 < nt) gloadK(t + 2);
    if (t + 1 < nt) gloadV(t + 1);
    const bf16_t* kbn = Ks + ((t + 1) & 1) * 64 * KWP; const bf16_t* vb = Vs + (t & 1) * 64 * 72;
    u32x4 vf[2][4];
#pragma unroll
    for (int dvb = 0; dvb < 2; ++dvb)
#pragma unroll
      for (int c4 = 0; c4 < 2; ++c4) {
        vf[dvb][c4] = *(const u32x4*)(vb + (dvb * 32 + r) * 72 + c4 * 16 + 8 * h);
      }
    __builtin_amdgcn_sched_barrier(0);
    unsigned u0 = __float_as_uint(sc[0][0]), u1 = __float_as_uint(sc[0][1]), u2 = __float_as_uint(sc[1][0]), u3 = __float_as_uint(sc[1][1]);
#pragma unroll
    for (int e = 2; e < 16; e += 2) {
      u0 = min(u0, min(__float_as_uint(sc[0][e]), __float_as_uint(sc[0][e + 1])));
      u1 = min(u1, min(__float_as_uint(sc[1][e]), __float_as_uint(sc[1][e + 1])));
    }
    u0 = min(min(u0, u1), min(u2, u3));
    {
      auto rr = __builtin_amdgcn_permlane32_swap(u0, u0, false, false);
      u0 = min((unsigned)rr[0], (unsigned)rr[1]);
    }
    const float REF_GAP = 8.f;
    const float rel = USE_NM ? 0.f : mref;
    const bool grow = (u0 < 0x80000000u) || (__uint_as_float(u0) - rel > -2.f);
    if (t == 0 || __any(grow)) {
      float m0 = fmaxf(sc[0][0], sc[0][1]), m1 = fmaxf(sc[0][2], sc[0][3]), m2 = fmaxf(sc[1][0], sc[1][1]), m3 = fmaxf(sc[1][2], sc[1][3]);
#pragma unroll
      for (int e = 4; e < 16; e += 4) {
        m0 = fmaxf(m0, fmaxf(sc[0][e], sc[0][e + 1])); m1 = fmaxf(m1, fmaxf(sc[0][e + 2], sc[0][e + 3]));
        m2 = fmaxf(m2, fmaxf(sc[1][e], sc[1][e + 1])); m3 = fmaxf(m3, fmaxf(sc[1][e + 2], sc[1][e + 3]));
      }
      const float mx = xhalf_max(fmaxf(fmaxf(m0, m1), fmaxf(m2, m3))) - rel;
      const float delta = (t == 0) ? mx + REF_GAP : fmaxf(mx + REF_GAP, 0.f);
      const float corr = __builtin_amdgcn_exp2f(-delta);
      lrun *= corr;
      mref += delta;
#pragma unroll
      for (int e = 0; e < 16; ++e) {
        if (USE_NM) { sc[0][e] -= delta; sc[1][e] -= delta; NM[e] -= delta; }
        O[0][e] *= corr; O[1][e] *= corr;
      }
    }
    float p0 = 0.f, p1 = 0.f, p2 = 0.f, p3 = 0.f;
    bf16x8 pf[4];
#pragma unroll
    for (int kb2 = 0; kb2 < 2; ++kb2)
#pragma unroll
      for (int s2 = 0; s2 < 2; ++s2) {
        float a[8];
#pragma unroll
        for (int e = 0; e < 8; ++e) a[e] = __builtin_amdgcn_exp2f(USE_NM ? sc[kb2][8 * s2 + e] : sc[kb2][8 * s2 + e] - mref);
        p0 += a[0] + a[4]; p1 += a[1] + a[5]; p2 += a[2] + a[6]; p3 += a[3] + a[7];
        u32x4 pu = {pack2(a[0], a[1]), pack2(a[2], a[3]), pack2(a[4], a[5]), pack2(a[6], a[7])};
        pf[kb2 * 2 + s2] = __builtin_bit_cast(bf16x8, pu);
      }
    lrun += (p0 + p1) + (p2 + p3);
    bf16x8 kf0[NKS], kf1[NKS];
#pragma unroll
    for (int ks = 0; ks < NKS; ++ks) kf0[ks] = *(const bf16x8*)(kbn + r * KWP + koff + ks * 16 + 8 * h);
    __builtin_amdgcn_sched_barrier(0);
#pragma unroll
    for (int c4 = 0; c4 < 2; ++c4)
#pragma unroll
      for (int dvb = 0; dvb < 2; ++dvb) O[dvb] = MFMA(__builtin_bit_cast(bf16x8, vf[dvb][c4]), pf[c4], O[dvb]);
#pragma unroll
    for (int dvb = 0; dvb < 2; ++dvb)
#pragma unroll
      for (int c4 = 2; c4 < 4; ++c4) {
        vf[dvb][c4] = *(const u32x4*)(vb + (dvb * 32 + r) * 72 + c4 * 16 + 8 * h);
      }
#pragma unroll
    for (int ks = 0; ks < NKS; ++ks) kf1[ks] = *(const bf16x8*)(kbn + (32 + r) * KWP + koff + ks * 16 + 8 * h);
    __builtin_amdgcn_sched_barrier(0);
    sc[0] = NM; sc[1] = NM;
#pragma unroll
    for (int ks = 0; ks < NKS; ++ks) sc[0] = MFMA(kf0[ks], qf[ks], sc[0]);
#pragma unroll
    for (int c4 = 2; c4 < 4; ++c4)
#pragma unroll
      for (int dvb = 0; dvb < 2; ++dvb) O[dvb] = MFMA(__builtin_bit_cast(bf16x8, vf[dvb][c4]), pf[c4], O[dvb]);
#pragma unroll
    for (int ks = 0; ks < NKS; ++ks) sc[1] = MFMA(kf1[ks], qf[ks], sc[1]);
    if (t + 2 < nt) storeK(t & 1);
    if (t + 1 < nt) storeV((t + 1) & 1);
    __syncthreads();
  }
  __builtin_amdgcn_s_setprio(0);
  u32x2 gall[2][4];
#pragma unroll
  for (int dvb = 0; dvb < 2; ++dvb)
#pragma unroll
    for (int g4 = 0; g4 < 4; ++g4) gall[dvb][g4] = *(const u32x2*)(gp + (size_t)qrow * ZS + dvb * 32 + 8 * g4 + 4 * h);
  const float lt = xhalf_sum(lrun);
  const float inv = 1.f / lt;
  if (DIFF) {
    if (sub == 1) {
#pragma unroll
      for (int dvb = 0; dvb < 2; ++dvb)
#pragma unroll
        for (int e = 0; e < 16; ++e) Xc[(rblk * 64 + dvb * 32 + crow(e, h)) * 32 + r] = O[dvb][e] * inv;
    }
    __syncthreads();
    if (sub == 0) {
      float ss = 0.f;
#pragma unroll
      for (int dvb = 0; dvb < 2; ++dvb)
#pragma unroll
        for (int e = 0; e < 16; ++e) { float v = O[dvb][e] * inv - lam * Xc[(rblk * 64 + dvb * 32 + crow(e, h)) * 32 + r]; O[dvb][e] = v; ss += v * v; }
      ss = xhalf_sum(ss);
      const float rstd = rsqrtf(ss * (1.f / 64.f) + EPSN) * post_scale;
#pragma unroll
      for (int dvb = 0; dvb < 2; ++dvb)
#pragma unroll
        for (int g4 = 0; g4 < 4; ++g4) {
          const int dv = dvb * 32 + 8 * g4 + 4 * h;
          const u32x2 gu = gall[dvb][g4];
          float g0 = silu_f(bflo(gu.x)), g1 = silu_f(bfhi(gu.x)), g2 = silu_f(bflo(gu.y)), g3 = silu_f(bfhi(gu.y));
          float o0 = O[dvb][4 * g4] * rstd * subln[dv] * g0, o1 = O[dvb][4 * g4 + 1] * rstd * subln[dv + 1] * g1;
          float o2 = O[dvb][4 * g4 + 2] * rstd * subln[dv + 2] * g2, o3 = O[dvb][4 * g4 + 3] * rstd * subln[dv + 3] * g3;
          u32x2 ou = {pack2(o0, o1), pack2(o2, o3)};
          *(u32x2*)(op + (size_t)qrow * ostride + dv) = ou;
        }
    }
  } else {
#pragma unroll
    for (int dvb = 0; dvb < 2; ++dvb)
#pragma unroll
      for (int g4 = 0; g4 < 4; ++g4) {
        const int dv = dvb * 32 + 8 * g4 + 4 * h;
        const u32x2 gu = gall[dvb][g4];
        float g0 = silu_f(bflo(gu.x)), g1 = silu_f(bfhi(gu.x)), g2 = silu_f(bflo(gu.y)), g3 = silu_f(bfhi(gu.y));
        float o0 = O[dvb][4 * g4] * inv * g0, o1 = O[dvb][4 * g4 + 1] * inv * g1;
        float o2 = O[dvb][4 * g4 + 2] * inv * g2, o3 = O[dvb][4 * g4 + 3] * inv * g3;
        u32x2 ou = {pack2(o0, o1), pack2(o2, o3)};
        *(u32x2*)(op + (size_t)qrow * ostride + dv) = ou;
      }
  }
}

DI void scan_item(const Params& p, int l, int seq, int hh, char* ldsraw0) {
  const int tid512 = opaque_tid();
  const int dir = tid512 >> 8;
  char* ldsraw = ldsraw0 + dir * 61440;
  bf16_t* Xs = (bf16_t*)ldsraw;
  float* Xf = (float*)(ldsraw + 9216);
  float* Aa = Xf + 4096;
  float* Bb = Aa + 4096;
  float* SegA = Bb + 4096;
  float* SegB = SegA + 256;
  float* carry = SegB + 256;
  const int tid = tid512 & 255, lane = tid & 63, w = tid >> 6, r = lane & 31, h = lane >> 5;
  const int mi = w >> 1, ni = w & 1;
  const int S = seq_len(seq), start = seq_start(seq);
  const bf16_t* z = (const bf16_t*)(p.ws + OFF_Z);
  bf16_t* zw = (bf16_t*)(p.ws + OFF_Z);
  bf16_t* hfb = (bf16_t*)(p.ws + OFF_HFB);
  const bf16_t* wl = (const bf16_t*)(p.ws + OFF_WLRU);
  bf16x8 wf[2][4];
#pragma unroll
  for (int mat = 0; mat < 2; ++mat)
#pragma unroll
    for (int ks = 0; ks < 4; ++ks)
      wf[mat][ks] = *(const bf16x8*)(wl + (size_t)((((l * 2 + dir) * 2 + mat) * 4 + hh) * 64 + ni * 32 + r) * 64 + ks * 16 + 8 * h);
  const int che = hh * 64 + ni * 32 + r;
  const float ba = p.lru_ba[(l * 2 + dir) * 256 + che], bx = p.lru_bx[(l * 2 + dir) * 256 + che];
  const float sp8 = 8.f * log1pf(expf(-p.lru_lambda[(l * 2 + dir) * 256 + che]));
  const int c = tid & 63, q = tid >> 6;
  const int chs = hh * 64 + c;
  const float cw0 = p.conv_w[(l * 4 + 0) * 256 + chs], cw1 = p.conv_w[(l * 4 + 1) * 256 + chs], cw2 = p.conv_w[(l * 4 + 2) * 256 + chs], cw3 = p.conv_w[(l * 4 + 3) * 256 + chs];
  const float cb = p.conv_b[l * 256 + chs];
  __syncthreads();
  if (tid < 128) carry[tid] = 0.f;
  const int ntile = S / 64;
  const bf16_t* zx = z + (size_t)start * ZS + ZC_XC + chs;
  const bf16_t* zg = z + (size_t)start * ZS + ZC_GC + chs;
  bf16_t xn[19];
  {
    const int sb = (dir ? S - 64 : 0) + q * 16 - 2;
#pragma unroll
    for (int e = 0; e < 19; ++e) { int sp = sb + e; xn[e] = (sp >= 0 && sp < S) ? zx[(size_t)sp * ZS] : (bf16_t)0; }
  }
  for (int tile = 0; tile < ntile; ++tile) {
    const int p0 = dir ? S - 64 * (tile + 1) : 64 * tile;
    float xv[19];
#pragma unroll
    for (int e = 0; e < 19; ++e) xv[e] = bf2f(xn[e]);
    if (tile + 1 < ntile) {
      const int sb = (dir ? S - 64 * (tile + 2) : 64 * (tile + 1)) + q * 16 - 2;
#pragma unroll
      for (int e = 0; e < 19; ++e) { int sp = sb + e; xn[e] = (sp >= 0 && sp < S) ? zx[(size_t)sp * ZS] : (bf16_t)0; }
    }
    const bool first = tile < (ntile >> 1);
    unsigned gp[16];
    if (!first) {
#pragma unroll
      for (int jj = 0; jj < 16; ++jj) {
        const int u = q * 16 + jj; const int tok = dir ? 63 - u : u;
        gp[jj] = (unsigned)zg[(size_t)(p0 + tok) * ZS] | ((unsigned)hfb[(size_t)(start + p0 + tok) * 512 + (1 - dir) * 256 + chs] << 16);
      }
    }
#pragma unroll
    for (int jj = 0; jj < 16; ++jj) {
      float xc = cb + cw0 * xv[jj] + cw1 * xv[jj + 1] + cw2 * xv[jj + 2] + cw3 * xv[jj + 3];
      Xs[(q * 16 + jj) * 72 + c] = f2bf(xc);
      Xf[(q * 16 + jj) * 64 + c] = xc;
    }
    __syncthreads();
    {
      f32x16 aR, aI;
#pragma unroll
      for (int e = 0; e < 16; ++e) { aR[e] = 0.f; aI[e] = 0.f; }
#pragma unroll
      for (int ks = 0; ks < 4; ++ks) {
        bf16x8 a = *(const bf16x8*)(Xs + (mi * 32 + r) * 72 + ks * 16 + 8 * h);
        aR = MFMA(a, wf[0][ks], aR);
        aI = MFMA(a, wf[1][ks], aI);
      }
#pragma unroll
      for (int i = 0; i < 16; ++i) {
        const int tok = mi * 32 + crow(i, h), ch = ni * 32 + r;
        const float rr = __builtin_amdgcn_rcpf(1.f + __expf(-(aR[i] + ba)));
        const float ii = __builtin_amdgcn_rcpf(1.f + __expf(-(aI[i] + bx)));
        const float xq = Xf[tok * 64 + ch];
        const float log_a = -sp8 * rr;
        const float a = __expf(log_a);
        const float x2 = 2.f * log_a;
        const float ser = -x2 * (1.f + x2 * (0.5f + x2 * (0.16666667f + x2 * 0.041666668f)));
        const float om = x2 > -0.1f ? ser : 1.f - __expf(x2);
        const float gx = __builtin_amdgcn_sqrtf(om) * (ii * xq);
        Aa[tok * 64 + ch] = a; Bb[tok * 64 + ch] = gx;
      }
    }
    __syncthreads();
    float Ac[16], Bc[16];
    {
      float A = 1.f, B = 0.f;
#pragma unroll
      for (int jj = 0; jj < 16; ++jj) {
        const int u = q * 16 + jj; const int tok = dir ? 63 - u : u;
        float a = Aa[tok * 64 + c], b = Bb[tok * 64 + c];
        B = a * B + b; A = A * a; Ac[jj] = A; Bc[jj] = B;
      }
      SegA[q * 64 + c] = A; SegB[q * 64 + c] = B;
    }
    __syncthreads();
    {
      float cin = carry[(tile & 1) * 64 + c];
      for (int qq = 0; qq < q; ++qq) cin = SegA[qq * 64 + c] * cin + SegB[qq * 64 + c];
#pragma unroll
      for (int jj = 0; jj < 16; ++jj) {
        const int u = q * 16 + jj; const int tok = dir ? 63 - u : u;
        float hv = Ac[jj] * cin + Bc[jj];
        const size_t trow = (size_t)(start + p0 + tok);
        if (first) hfb[trow * 512 + dir * 256 + chs] = f2bf(hv);
        else zw[trow * ZS + ZC_GC + chs] = f2bf((hv + bfhi(gp[jj])) * silu_f(bflo(gp[jj])));
        if (jj == 15 && q == 3) carry[((tile + 1) & 1) * 64 + c] = hv;
      }
    }
    __syncthreads();
  }
}

DI void phase_mix(const Params& p, int l, char* ldsraw) {
  __shared__ int s_item;
  const int tid = threadIdx.x;
  const int x = blockIdx.x & 7;
  int* ctr = (int*)(p.ws + OFF_CTR) + l * 8 + x;
  bf16_t* z = (bf16_t*)(p.ws + OFF_Z);
  bf16_t* QA = (bf16_t*)(p.ws + OFF_QA);
  bf16_t* KA = (bf16_t*)(p.ws + OFF_KA);
  const bf16_t* VTA = (const bf16_t*)(p.ws + OFF_VTA);
  const bf16_t* VTB = (const bf16_t*)(p.ws + OFF_VTB);
  const bf16_t* VTD = (const bf16_t*)(p.ws + OFF_VTD);
  const float lam = ((const float*)(p.ws + OFF_LAM))[l];
  const float lam_init = l == 0 ? 0.2f : 0.8f - 0.6f * 0.7408182206817179f;
  constexpr int N_ITEMS = 16 + 512 + 256;
  while (true) {
    __syncthreads();
    if (tid == 0) s_item = atomicAdd(ctr, 1);
    __syncthreads();
    int j = __builtin_amdgcn_readfirstlane(s_item);
    if (j >= N_ITEMS) break;
    if (j < 16) { const int id = j * 8 + x; scan_item(p, l, id >> 2, id & 3, ldsraw); continue; }
    j -= 16;
    int type, seq, head, qt;
    if (j < 512) {
      if (j < 256) { type = 1; const int gg = (j >> 5) * 8 + x; seq = gg >> 2; head = gg & 3; qt = j & 31; }
      else { type = j < 384 ? 2 : 0; const int jj = j & 127; const int gg = (jj >> 4) * 8 + x; seq = gg >> 2; head = gg & 3; qt = jj & 15; }
    } else {
      j -= 512;
      if (j < 128) { type = 1; const int gg = (j >> 4) * 8 + x; seq = 16 + (gg >> 2); head = gg & 3; qt = j & 15; }
      else { type = j < 192 ? 2 : 0; const int jj = j & 63; const int gg = (jj >> 3) * 8 + x; seq = 16 + (gg >> 2); head = gg & 3; qt = jj & 7; }
    }
    const int S = seq_len(seq), start = seq_start(seq);
    if (type == 0) {
      attn_item<96, 96, false>(QA + head * 96, 384, KA + head * 96, 384, VTA + (size_t)start * 256 + (size_t)head * 64 * S,
                               z + ZC_VB + head * 64, ZS, z + ZC_GA + head * 64, S, start, qt, (bf16_t*)ldsraw, 0.f, 0.f, nullptr);
    } else if (type == 1) {
      attn_item<32, 64, true>(z + ZC_QB + head * 64, ZS, z + ZC_KB + head * 64, ZS, VTB + (size_t)start * 256 + (size_t)head * 64 * S,
                              z + ZC_QB + head * 64, ZS, z + ZC_GB + head * 64, S, start, qt, (bf16_t*)ldsraw, lam, 1.f - lam_init, p.diff_subln + l * 64);
    } else {
      attn_item<64, 64, false>(z + ZC_QD + head * 64, ZS, z + ZC_KD + (head >> 1) * 64, ZS, VTD + (size_t)start * 128 + (size_t)(head >> 1) * 64 * S,
                               z + ZC_QD + head * 64, ZS, z + ZC_GD + head * 64, S, start, qt, (bf16_t*)ldsraw, 0.f, 0.f, nullptr);
    }
  }
}

DI void phase_outproj(const Params& p, int l, bf16_t* lds) {
  const bf16_t* z = (const bf16_t*)(p.ws + OFF_Z);
  const bf16_t* QA = (const bf16_t*)(p.ws + OFF_QA);
  const bf16_t* hfb = (const bf16_t*)(p.ws + OFF_HFB);
  const bf16_t* wt = (const bf16_t*)(p.ws + OFF_WOUT) + (size_t)l * 1024 * 1024;
  const float* modp = (const float*)(p.ws + OFF_MOD) + (size_t)l * 32 * 3072;
  const int lane = opaque_tid() & 63, r = lane & 31, h = lane >> 5;
  constexpr int NT = 4, MT = T_TOK / 256;
  {
    gemm_stream(z, ZS,
        [&](int kt) {
          const int grp = kt >> 2, sub = kt & 3;
          const int col = grp == 0 ? ZC_VB : (grp == 1 ? ZC_QB : (grp == 2 ? ZC_GC : ZC_QD));
          return col + sub * 64;
        },
        wt, 1024, 16,
        [&](int q, int& tm0, int& tn0) { int mt, nt; const bool v = xcd_tile(q, NT, MT, mt, nt); tm0 = mt * 256; tn0 = nt * 256; return v; },
        [&](int m0, int n64, const f32x16& acc0, const f32x16& acc1) {
         const int lane = opaque_tid() & 63, r = lane & 31, h = lane >> 5;
         const int n = n64 + r;
         int seq, s; tok2seq(m0, seq, s);
         const float gate0 = modp[seq * 3072 + 2048 + n], gate1 = modp[seq * 3072 + 2048 + n + 32];
         const float* xb = (l == 0) ? (m0 < T_P ? p.xin0 + (size_t)m0 * 1024 : p.xin1 + (size_t)(m0 - T_P) * 1024) : p.out + (size_t)m0 * 1024;
         xb += (size_t)(4 * h) * 1024 + n;
         float* ob = p.out + (size_t)(m0 + 4 * h) * 1024 + n;
         float x0[16], x1[16];
#pragma unroll
         for (int i = 0; i < 16; ++i) { const int ro = ((i & 3) + 8 * (i >> 2)) * 1024; x0[i] = xb[ro]; x1[i] = xb[ro + 32]; }
#pragma unroll
         for (int i = 0; i < 16; ++i) { const int ro = ((i & 3) + 8 * (i >> 2)) * 1024; ob[ro] = x0[i] + gate0 * acc0[i]; ob[ro + 32] = x1[i] + gate1 * acc1[i]; }
        },
        lds);
  }
}

__global__ void __launch_bounds__(512, 2) hymba_fwd(Params p) {
  cg::grid_group grid = cg::this_grid();
  unsigned* gbar = (unsigned*)(p.ws + OFF_CTR) + 48;
  const unsigned nblk = gridDim.x;
  unsigned gb_n = 0;
  __shared__ __attribute__((aligned(16))) char lds[147456];
  phase0a(p, (float*)lds);
  grid.sync();
  phase_norm(p, 0, 0, true);
  grid_barrier(gbar, nblk * (++gb_n));
#pragma unroll 1
  for (int l = 0; l < 2; ++l) {
    phase_inproj(p, l, (bf16_t*)lds);
    grid_barrier(gbar, nblk * (++gb_n));
    phase_mla_up(p, l, (bf16_t*)lds);
    grid_barrier(gbar, nblk * (++gb_n));
    phase_mix(p, l, lds);
    grid_barrier(gbar, nblk * (++gb_n));
    phase_outproj(p, l, (bf16_t*)lds);
    grid_barrier(gbar, nblk * (++gb_n));
    if (l == 0) { phase_norm(p, 1, 0, false); grid_barrier(gbar, nblk * (++gb_n)); }
    else phase_norm(p, 0, 1, false);
  }
}

extern "C" void kernel_launch(void* const* d_in, const int* in_sizes, int n_in, void* d_out, int out_size, void* d_ws, size_t ws_size, hipStream_t stream) {
  if (ws_size < WS_NEED) { fprintf(stderr, "workspace too small: %zu < %zu\n", ws_size, (size_t)WS_NEED); return; }
  static int grid_blocks = 0;
  if (!grid_blocks) {
    int dev = 0, cus = 0, per_cu = 0;
    hipGetDevice(&dev);
    hipDeviceGetAttribute(&cus, hipDeviceAttributeMultiprocessorCount, dev);
    hipOccupancyMaxActiveBlocksPerMultiprocessor(&per_cu, hymba_fwd, 512, 0);
    if (per_cu > 1) per_cu = 1;
    if (per_cu < 1) per_cu = 1;
    grid_blocks = (cus * per_cu) & ~7;
  }
  Params p{};
  p.xin0 = (const float*)d_in[0]; p.xin1 = (const float*)d_in[1]; p.c0 = (const float*)d_in[2]; p.c1 = (const float*)d_in[3];
  p.ada_w = (const float*)d_in[4]; p.ada_b = (const float*)d_in[5]; p.norm_g = (const float*)d_in[6]; p.w_in = (const float*)d_in[7];
  p.mla_q_norm = (const float*)d_in[8]; p.mla_w_uq = (const float*)d_in[9]; p.mla_kv_norm = (const float*)d_in[10]; p.mla_w_ukv = (const float*)d_in[11];
  p.diff_lambda = (const float*)d_in[12]; p.diff_subln = (const float*)d_in[13]; p.conv_w = (const float*)d_in[14]; p.conv_b = (const float*)d_in[15];
  p.lru_wa = (const float*)d_in[16]; p.lru_ba = (const float*)d_in[17]; p.lru_wx = (const float*)d_in[18]; p.lru_bx = (const float*)d_in[19];
  p.lru_lambda = (const float*)d_in[20]; p.gqa_q_norm = (const float*)d_in[21]; p.gqa_k_norm = (const float*)d_in[22]; p.w_out = (const float*)d_in[23];
  p.final_norm = (const float*)d_in[24];
  p.out = (float*)d_out; p.ws = (char*)d_ws;
  hipMemsetAsync((char*)d_ws + OFF_CTR, 0, 256, stream);
  void* args[] = {&p};
  hipError_t e = hipLaunchCooperativeKernel((void*)hymba_fwd, dim3(grid_blocks), dim3(512), args, 0, stream);
  if (e != hipSuccess) fprintf(stderr, "cooperative launch failed: %s (grid %d)\n", hipGetErrorString(e), grid_blocks);
}
```

```cpp
#include <hip/hip_runtime.h>
#include <hip/hip_cooperative_groups.h>
#include <cstdio>
#include <cstdint>
namespace cg = cooperative_groups;

typedef unsigned short bf16_t;
using bf16x8 = __attribute__((ext_vector_type(8))) short;
using f32x16 = __attribute__((ext_vector_type(16))) float;
typedef __bf16 bf16x2_t __attribute__((ext_vector_type(2)));
typedef float f32x2_t __attribute__((ext_vector_type(2)));
using u32x4 = __attribute__((ext_vector_type(4))) unsigned;
using u32x2 = __attribute__((ext_vector_type(2))) unsigned;
#define DI __device__ __forceinline__
#define MFMA(a, b, c) __builtin_amdgcn_mfma_f32_32x32x16_bf16((a), (b), (c), 0, 0, 0)

constexpr int T_TOK = 98304, T_P = 65536, DM = 1024, ZS = 2944, NIN = 2912;
constexpr int ZC_QB = 0, ZC_KB = 256, ZC_VB = 512, ZC_GB = 768, ZC_XC = 1024, ZC_GC = 1280, ZC_QD = 1536,
              ZC_KD = 1792, ZC_VD = 1920, ZC_GD = 2048, ZC_GA = 2304, ZC_QA = 2560, ZC_KVA = 2752, ZC_KRA = 2880;
constexpr float LOG2E = 1.4426950408889634f;
constexpr float EPSN = 1e-6f;

constexpr size_t OFF_H = 0;
constexpr size_t SZ_H = (size_t)T_TOK * 1024 * 2;
constexpr size_t OFF_QA = OFF_H;
constexpr size_t OFF_KA = OFF_H + (size_t)T_TOK * 384 * 2;
constexpr size_t OFF_VTA = OFF_H + (size_t)T_TOK * 768 * 2;
constexpr size_t OFF_Z = OFF_H + SZ_H;
constexpr size_t OFF_VTB = OFF_Z + (size_t)T_TOK * ZS * 2;
constexpr size_t OFF_VTD = OFF_VTB + (size_t)T_TOK * 256 * 2;
constexpr size_t OFF_HFB = OFF_VTD + (size_t)T_TOK * 128 * 2;
constexpr size_t OFF_WIN = OFF_HFB + (size_t)T_TOK * 512 * 2;
constexpr size_t OFF_WOUT = OFF_WIN + (size_t)2 * 3072 * 1024 * 2;
constexpr size_t OFF_WUQ = OFF_WOUT + (size_t)2 * 1024 * 1280 * 2;
constexpr size_t OFF_WUKV = OFF_WUQ + (size_t)2 * 512 * 192 * 2;
constexpr size_t OFF_WLRU = OFF_WUKV + (size_t)2 * 512 * 128 * 2;
constexpr size_t OFF_MOD = OFF_WLRU + (size_t)2 * 2 * 2 * 4 * 64 * 64 * 2;
constexpr size_t OFF_TABM = OFF_MOD + (size_t)2 * 32 * 3072 * 4;
constexpr size_t OFF_TABP = OFF_TABM + (size_t)4096 * 16 * 8;
constexpr size_t OFF_TABX = OFF_TABP + (size_t)4096 * 4 * 8;
constexpr size_t OFF_LAM = OFF_TABX + (size_t)64 * 16 * 8;
constexpr size_t OFF_CTR = OFF_LAM + 256;
constexpr size_t OFF_RSS = OFF_CTR + 256;
constexpr size_t WS_NEED = OFF_RSS + (size_t)T_TOK * 8 * 4;

struct Params {
  const float* xin0; const float* xin1; const float* c0; const float* c1;
  const float *ada_w, *ada_b, *norm_g, *w_in, *mla_q_norm, *mla_w_uq, *mla_kv_norm, *mla_w_ukv,
      *diff_lambda, *diff_subln, *conv_w, *conv_b, *lru_wa, *lru_ba, *lru_wx, *lru_bx, *lru_lambda,
      *gqa_q_norm, *gqa_k_norm, *w_out, *final_norm;
  float* out;
  char* ws;
};

DI unsigned pack2(float a, float b) { f32x2_t v = {a, b}; bf16x2_t o = __builtin_convertvector(v, bf16x2_t); return __builtin_bit_cast(unsigned, o); }
DI bf16_t f2bf(float a) { return (bf16_t)(pack2(a, 0.f) & 0xffffu); }
DI float bf2f(bf16_t v) { return __uint_as_float(((unsigned)v) << 16); }
DI float bflo(unsigned u) { return __uint_as_float(u << 16); }
DI float bfhi(unsigned u) { return __uint_as_float(u & 0xffff0000u); }
DI int opaque_tid() { int t = threadIdx.x; asm volatile("" : "+v"(t)); return t; }
DI int crow(int i, int h) { return (i & 3) + 8 * (i >> 2) + 4 * h; }
DI int seq_start(int seq) { return seq < 16 ? (seq << 12) : T_P + ((seq - 16) << 11); }
DI int seq_len(int seq) { return seq < 16 ? 4096 : 2048; }
DI void tok2seq(int t, int& seq, int& s) { if (t < T_P) { seq = t >> 12; s = t & 4095; } else { int u = t - T_P; seq = 16 + (u >> 11); s = u & 2047; } }
DI float silu_f(float x) { return x / (1.f + __expf(-x)); }
DI float sigmoid_f(float x) { return 1.f / (1.f + __expf(-x)); }
DI float xhalf_max(float v) { unsigned u = __float_as_uint(v); auto rr = __builtin_amdgcn_permlane32_swap(u, u, false, false); return fmaxf(__uint_as_float(rr[0]), __uint_as_float(rr[1])); }
DI float xhalf_sum(float v) { unsigned u = __float_as_uint(v); auto rr = __builtin_amdgcn_permlane32_swap(u, u, false, false); return __uint_as_float(rr[0]) + __uint_as_float(rr[1]); }
DI void grid_barrier(unsigned* ctr, unsigned target) {
  __syncthreads();
  if (threadIdx.x == 0) {
    __threadfence();
    atomicAdd(ctr, 1u);
    while (__hip_atomic_load(ctr, __ATOMIC_RELAXED, __HIP_MEMORY_SCOPE_AGENT) < target) __builtin_amdgcn_s_sleep(4);
    __threadfence();
  }
  __syncthreads();
}
DI float wave_sum(float v) {
  v += __shfl_xor(v, 32); v += __shfl_xor(v, 16); v += __shfl_xor(v, 8); v += __shfl_xor(v, 4); v += __shfl_xor(v, 2); v += __shfl_xor(v, 1);
  return v;
}

constexpr int G_LDP = 72;
constexpr int G_STAGE = 512 * G_LDP;
template <class ASrc, class Epi>
DI void gemm_tile(ASrc asrc, const bf16_t* __restrict__ Bt, int ldb, int nk, int m0, int n0, Epi epi, bf16_t* lds) {
  const int tid = opaque_tid(), lane = tid & 63, w = tid >> 6, r = lane & 31, h = lane >> 5;
  const int wm = w >> 2, wn = w & 3;
  f32x16 acc[4][2];
#pragma unroll
  for (int mi = 0; mi < 4; ++mi)
#pragma unroll
    for (int ni = 0; ni < 2; ++ni)
#pragma unroll
      for (int i = 0; i < 16; ++i) acc[mi][ni][i] = 0.f;
  u32x4 ra[4], rb[4];
  const int lrow = tid >> 3, lch = tid & 7;
  auto gload = [&](int kt) {
    const bf16_t* ab; int as; asrc(kt, ab, as);
#pragma unroll
    for (int i = 0; i < 4; ++i) ra[i] = *(const u32x4*)(ab + (size_t)(m0 + lrow + 64 * i) * as + lch * 8);
#pragma unroll
    for (int i = 0; i < 4; ++i) rb[i] = *(const u32x4*)(Bt + (size_t)(n0 + lrow + 64 * i) * ldb + kt * 64 + lch * 8);
  };
  auto lstore = [&](int buf) {
    bf16_t* As = lds + buf * G_STAGE; bf16_t* Bs = As + 256 * G_LDP;
#pragma unroll
    for (int i = 0; i < 4; ++i) *(u32x4*)(As + (lrow + 64 * i) * G_LDP + lch * 8) = ra[i];
#pragma unroll
    for (int i = 0; i < 4; ++i) *(u32x4*)(Bs + (lrow + 64 * i) * G_LDP + lch * 8) = rb[i];
  };
  __syncthreads();
  gload(0);
  lstore(0);
  gload(1);
  for (int t = 0; t < nk; ++t) {
    __syncthreads();
    if (t + 1 < nk) lstore((t + 1) & 1);
    if (t + 2 < nk) gload(t + 2);
    const bf16_t* As = lds + (t & 1) * G_STAGE; const bf16_t* Bs = As + 256 * G_LDP;
#pragma unroll
    for (int ks = 0; ks < 4; ++ks) {
      bf16x8 a[4], b[2];
#pragma unroll
      for (int mi = 0; mi < 4; ++mi) a[mi] = *(const bf16x8*)(As + (wm * 128 + mi * 32 + r) * G_LDP + ks * 16 + 8 * h);
#pragma unroll
      for (int ni = 0; ni < 2; ++ni) b[ni] = *(const bf16x8*)(Bs + (wn * 64 + ni * 32 + r) * G_LDP + ks * 16 + 8 * h);
#pragma unroll
      for (int mi = 0; mi < 4; ++mi)
#pragma unroll
        for (int ni = 0; ni < 2; ++ni) acc[mi][ni] = MFMA(a[mi], b[ni], acc[mi][ni]);
    }
  }
#pragma unroll
  for (int mi = 0; mi < 4; ++mi)
#pragma unroll
    for (int ni = 0; ni < 2; ++ni) epi(m0 + wm * 128 + mi * 32, n0 + wn * 64 + ni * 32, acc[mi][ni]);
}

template <class ACol, class TileFn, class Epi>
DI void gemm_stream(const bf16_t* __restrict__ Abase, int as, ACol acol, const bf16_t* __restrict__ Bt, int ldb, int nk, TileFn tile_fn, Epi epi, bf16_t* lds) {
  const int tid = opaque_tid(), lane = tid & 63, w = tid >> 6, r = lane & 31, h = lane >> 5;
  const int wm = w >> 2, wn = w & 3;
  u32x4 ra[4], rb[4];
  const int lrow = tid >> 3, lch = tid & 7;
  const bf16_t* ap; const bf16_t* bp;
  auto gload = [&](int kt) {
    const int ac = acol(kt);
#pragma unroll
    for (int i = 0; i < 4; ++i) ra[i] = *(const u32x4*)(ap + (size_t)(64 * i) * as + ac);
#pragma unroll
    for (int i = 0; i < 4; ++i) rb[i] = *(const u32x4*)(bp + (size_t)(64 * i) * ldb + kt * 64);
  };
  auto lstore = [&](int buf) {
    bf16_t* As = lds + buf * G_STAGE; bf16_t* Bs = As + 256 * G_LDP;
#pragma unroll
    for (int i = 0; i < 4; ++i) *(u32x4*)(As + (lrow + 64 * i) * G_LDP + lch * 8) = ra[i];
#pragma unroll
    for (int i = 0; i < 4; ++i) *(u32x4*)(Bs + (lrow + 64 * i) * G_LDP + lch * 8) = rb[i];
  };
  int q = blockIdx.x >> 3; const int qstep = gridDim.x >> 3;
  int m0, n0;
  if (!tile_fn(q, m0, n0)) return;
  ap = Abase + (size_t)(m0 + lrow) * as + lch * 8; bp = Bt + (size_t)(n0 + lrow) * ldb + lch * 8;
  gload(0);
  while (true) {
    f32x16 acc[4][2];
#pragma unroll
    for (int mi = 0; mi < 4; ++mi)
#pragma unroll
      for (int ni = 0; ni < 2; ++ni)
#pragma unroll
        for (int i = 0; i < 16; ++i) acc[mi][ni][i] = 0.f;
    __syncthreads();
    lstore(0);
    gload(1);
    for (int t = 0; t < nk; ++t) {
      __syncthreads();
      const bf16_t* As = lds + (t & 1) * G_STAGE; const bf16_t* Bs = As + 256 * G_LDP;
      bf16_t* Asn = lds + ((t + 1) & 1) * G_STAGE; bf16_t* Bsn = Asn + 256 * G_LDP;
      const int ac2 = (t + 2 < nk) ? acol(t + 2) : 0;
#pragma unroll
      for (int ks = 0; ks < 4; ++ks) {
        bf16x8 a[4], b[2];
#pragma unroll
        for (int mi = 0; mi < 4; ++mi) a[mi] = *(const bf16x8*)(As + (wm * 128 + mi * 32 + r) * G_LDP + ks * 16 + 8 * h);
#pragma unroll
        for (int ni = 0; ni < 2; ++ni) b[ni] = *(const bf16x8*)(Bs + (wn * 64 + ni * 32 + r) * G_LDP + ks * 16 + 8 * h);
        __builtin_amdgcn_sched_barrier(0);
#pragma unroll
        for (int mi = 0; mi < 4; ++mi)
#pragma unroll
          for (int ni = 0; ni < 2; ++ni) acc[mi][ni] = MFMA(a[mi], b[ni], acc[mi][ni]);
        if (t + 1 < nk) {
          *(u32x4*)(Asn + (lrow + 64 * ks) * G_LDP + lch * 8) = ra[ks];
          *(u32x4*)(Bsn + (lrow + 64 * ks) * G_LDP + lch * 8) = rb[ks];
        }
        if (t + 2 < nk) {
          ra[ks] = *(const u32x4*)(ap + (size_t)(64 * ks) * as + ac2);
          rb[ks] = *(const u32x4*)(bp + (size_t)(64 * ks) * ldb + (t + 2) * 64);
        }
      }
    }
    q += qstep;
    int m1, n1;
    const bool v1 = tile_fn(q, m1, n1);
    if (v1) { ap = Abase + (size_t)(m1 + lrow) * as + lch * 8; bp = Bt + (size_t)(n1 + lrow) * ldb + lch * 8; gload(0); }
#pragma unroll
    for (int mi = 0; mi < 4; ++mi) epi(m0 + wm * 128 + mi * 32, n0 + wn * 64, acc[mi][0], acc[mi][1]);
    if (!v1) break;
    m0 = m1; n0 = n1;
  }
}

DI bool xcd_tile(int q, int n_sub, int n_mt, int& mt, int& sub) {
  const int x = blockIdx.x & 7;
  const int mloc = q / n_sub; sub = q - mloc * n_sub;
  mt = mloc * 8 + x;
  return mt < n_mt;
}

template <class SrcFn>
DI void transpose64(SrcFn src, bf16_t* dst, int dld, int k0, int n0, float* tile) {
  const int tid = opaque_tid();
  __syncthreads();
  {
    const int nn = tid & 63, kq = tid >> 6;
#pragma unroll 4
    for (int i = 0; i < 8; ++i) { int kk = kq + 8 * i; tile[kk * 65 + nn] = src(k0 + kk, n0 + nn); }
  }
  __syncthreads();
  {
    const int kk2 = (tid & 31) * 2, nq = tid >> 5;
#pragma unroll 4
    for (int i = 0; i < 4; ++i) {
      int nn2 = nq + 16 * i;
      *(unsigned*)(dst + (size_t)(n0 + nn2) * dld + k0 + kk2) = pack2(tile[kk2 * 65 + nn2], tile[(kk2 + 1) * 65 + nn2]);
    }
  }
}

DI int win_perm(int n) {
  if (n < 2304) return n + 608;
  if (n < 2560) return n - 2304 + 352;
  if (n < 2752) return n - 2560;
  if (n < 2880) return n - 2752 + 192;
  if (n < 2912) return n - 2880 + 320;
  return -1;
}

DI void mod_item(const Params& p, int l, int nc, float* lds) {
  float* sc = lds;
  float* red = lds + 8192;
  const int tid = opaque_tid(), col = tid & 63, kq = tid >> 6;
  const int n = nc * 64 + col;
  float acc[32];
#pragma unroll
  for (int i = 0; i < 32; ++i) acc[i] = 0.f;
  const float* W = p.ada_w + (size_t)l * 1024 * 3072;
  for (int st = 0; st < 4; ++st) {
    __syncthreads();
    for (int e = 0; e < 16; ++e) {
      int idx = e * 512 + tid; int seq = idx >> 8, kk = idx & 255;
      const float* cp = seq < 16 ? p.c0 + seq * 1024 : p.c1 + (seq - 16) * 1024;
      sc[kk * 32 + seq] = silu_f(cp[st * 256 + kk]);
    }
    __syncthreads();
    for (int kk0 = 0; kk0 < 32; kk0 += 8) {
      float wv[8];
#pragma unroll
      for (int u = 0; u < 8; ++u) wv[u] = W[(size_t)(st * 256 + kq * 32 + kk0 + u) * 3072 + n];
#pragma unroll
      for (int u = 0; u < 8; ++u) {
        const float4* s4 = (const float4*)(sc + (kq * 32 + kk0 + u) * 32);
#pragma unroll
        for (int j = 0; j < 8; ++j) { float4 v = s4[j]; acc[4 * j] += v.x * wv[u]; acc[4 * j + 1] += v.y * wv[u]; acc[4 * j + 2] += v.z * wv[u]; acc[4 * j + 3] += v.w * wv[u]; }
      }
    }
  }
  __syncthreads();
#pragma unroll
  for (int i = 0; i < 32; ++i) red[(kq * 32 + i) * 64 + col] = acc[i];
  __syncthreads();
  float* modp = (float*)(p.ws + OFF_MOD) + (size_t)l * 32 * 3072;
  for (int e = 0; e < 4; ++e) {
    int seq = kq * 4 + e;
    float v = 0.f;
#pragma unroll
    for (int g = 0; g < 8; ++g) v += red[(g * 32 + seq) * 64 + col];
    modp[seq * 3072 + n] = v + p.ada_b[l * 3072 + n];
  }
  __syncthreads();
}

DI void phase0a(const Params& p, float* lds) {
  const int tid = opaque_tid();
  bf16_t* wt_in = (bf16_t*)(p.ws + OFF_WIN);
  bf16_t* wt_out = (bf16_t*)(p.ws + OFF_WOUT);
  bf16_t* wt_uq = (bf16_t*)(p.ws + OFF_WUQ);
  bf16_t* wt_ukv = (bf16_t*)(p.ws + OFF_WUKV);
  bf16_t* wlru = (bf16_t*)(p.ws + OFF_WLRU);
  constexpr int N_MOD = 96, N_WIN = 2 * 48 * 16, N_WOUT = 2 * 16 * 16, N_WUQ = 2 * 8 * 3, N_WUKV = 2 * 8 * 2, N_LRU = 32, N_TAB = 162;
  constexpr int N_ALL = N_MOD + N_WIN + N_WOUT + N_WUQ + N_WUKV + N_LRU + N_TAB + 1;
  for (int it = blockIdx.x; it < N_ALL; it += gridDim.x) {
    int j = it;
    if (j < N_MOD) { mod_item(p, j / 48, j % 48, lds); continue; }
    j -= N_MOD;
    if (j < N_WIN) {
      int l = j / (48 * 16), rem = j % (48 * 16), nt = rem / 16, kt = rem % 16;
      const float* src = p.w_in + (size_t)l * 1024 * NIN;
      transpose64([&](int k, int n) { int on = win_perm(n); return on >= 0 ? src[(size_t)k * NIN + on] : 0.f; },
                  wt_in + (size_t)l * 3072 * 1024, 1024, kt * 64, nt * 64, lds);
      continue;
    }
    j -= N_WIN;
    if (j < N_WOUT) {
      int l = j / (16 * 16), rem = j % (16 * 16), nt = rem / 16, kt = rem % 16;
      const float* src = p.w_out + (size_t)l * 1024 * 1024;
      transpose64([&](int k, int n) { return src[(size_t)k * 1024 + n]; },
                  wt_out + (size_t)l * 1024 * 1024, 1024, kt * 64, nt * 64, lds);
      continue;
    }
    j -= N_WOUT;
    if (j < N_WUQ) {
      int l = j / 24, rem = j % 24, nt = rem / 3, kt = rem % 3;
      const float* src = p.mla_w_uq + (size_t)l * 192 * 384;
      const float* gq = p.mla_q_norm + l * 192;
      transpose64([&](int k, int n) { return n < 384 ? src[(size_t)k * 384 + n] * gq[k] : 0.f; }, wt_uq + (size_t)l * 512 * 192, 192, kt * 64, nt * 64, lds);
      continue;
    }
    j -= N_WUQ;
    if (j < N_WUKV) {
      int l = j / 16, rem = j % 16, nt = rem / 2, kt = rem % 2;
      const float* src = p.mla_w_ukv + (size_t)l * 128 * 512;
      const float* gk = p.mla_kv_norm + l * 128;
      transpose64([&](int k, int n) { return src[(size_t)k * 512 + n] * gk[k]; }, wt_ukv + (size_t)l * 512 * 128, 128, kt * 64, nt * 64, lds);
      continue;
    }
    j -= N_WUKV;
    if (j < N_LRU) {
      int hh = j & 3, mat = (j >> 2) & 1, d = (j >> 3) & 1, l = j >> 4;
      const float* src = (mat ? p.lru_wx : p.lru_wa) + (size_t)((l * 2 + d) * 4 + hh) * 4096;
      transpose64([&](int k, int n) { return src[k * 64 + n]; }, wlru + (size_t)j * 4096, 64, 0, 0, lds);
      continue;
    }
    j -= N_LRU;
    if (j < N_TAB) {
      int e = j * 512 + tid;
      float2* tm = (float2*)(p.ws + OFF_TABM); float2* tp = (float2*)(p.ws + OFF_TABP); float2* tx = (float2*)(p.ws + OFF_TABX);
      if (e < 65536) { int pos = e >> 4, f = e & 15; float inv = powf(10000.f, -(float)f / 16.f); float a = (float)pos * inv; tm[e] = make_float2(cosf(a), sinf(a)); }
      else if (e < 65536 + 16384) { int q = e - 65536; int pos = q >> 2, f = q & 3; float inv = powf(500000.f, -(float)f / 4.f); float a = (float)pos * inv; tp[q] = make_float2(cosf(a), sinf(a)); }
      else if (e < 65536 + 16384 + 1024) { int q = e - 65536 - 16384; int pos = q >> 4, f = q & 15; float inv = powf(10000.f, -(float)f / 16.f); float a = (float)pos * inv; tx[q] = make_float2(cosf(a), sinf(a)); }
      continue;
    }
    if (tid < 2) {
      int l = tid; const float* lf = p.diff_lambda + l * 128;
      float s1 = 0.f, s2 = 0.f;
      for (int i = 0; i < 32; ++i) { s1 += lf[i] * lf[32 + i]; s2 += lf[64 + i] * lf[96 + i]; }
      float lam_init = 0.8f - 0.6f * expf(-0.3f * (float)l);
      ((float*)(p.ws + OFF_LAM))[l] = expf(s1) - expf(s2) + lam_init;
    }
  }
}

DI void phase_norm(const Params& p, int l, int mode, bool from_input) {
  using f32x4 = __attribute__((ext_vector_type(4))) float;
  const int tid = opaque_tid(), lane = tid & 63, w = tid >> 6;
  bf16_t* hbuf = (bf16_t*)(p.ws + OFF_H);
  const float* modp = (const float*)(p.ws + OFF_MOD) + (size_t)l * 32 * 3072;
  const float* g = mode == 0 ? p.norm_g + l * 1024 : p.final_norm;
  for (int it = blockIdx.x; it < T_TOK / 32; it += gridDim.x) {
    const int t0 = it * 32 + w * 4;
    const float* xr0 = from_input ? (t0 < T_P ? p.xin0 + (size_t)t0 * 1024 : p.xin1 + (size_t)(t0 - T_P) * 1024) : p.out + (size_t)t0 * 1024;
    f32x4 v[4][4];
#pragma unroll
    for (int rr = 0; rr < 4; ++rr)
#pragma unroll
      for (int j = 0; j < 4; ++j) v[rr][j] = __builtin_nontemporal_load((const f32x4*)(xr0 + rr * 1024 + j * 256 + lane * 4));
    f32x4 gs[4], sh4[4];
    {
      int seq, s; tok2seq(t0, seq, s);
      const float* sh = modp + seq * 3072; const float* scl = sh + 1024;
#pragma unroll
      for (int j = 0; j < 4; ++j) {
        const int k = j * 256 + lane * 4;
        f32x4 gg = *(const f32x4*)(g + k);
        if (mode == 0) { f32x4 s4 = *(const f32x4*)(scl + k); gs[j] = gg * (1.f + s4); sh4[j] = *(const f32x4*)(sh + k); }
        else { gs[j] = gg; sh4[j] = gg * 0.f; }
      }
    }
#pragma unroll
    for (int rr = 0; rr < 4; ++rr) {
      float ss = 0.f;
#pragma unroll
      for (int j = 0; j < 4; ++j) ss += v[rr][j].x * v[rr][j].x + v[rr][j].y * v[rr][j].y + v[rr][j].z * v[rr][j].z + v[rr][j].w * v[rr][j].w;
      ss = wave_sum(ss);
      const float rstd = rsqrtf(ss * (1.f / 1024.f) + EPSN);
      const int t = t0 + rr;
#pragma unroll
      for (int j = 0; j < 4; ++j) {
        const int k = j * 256 + lane * 4;
        f32x4 o = v[rr][j] * rstd * gs[j] + sh4[j];
        if (mode == 0) {
          u32x2 ou = {pack2(o.x, o.y), pack2(o.z, o.w)};
          *(u32x2*)(hbuf + (size_t)t * 1024 + k) = ou;
        } else {
          __builtin_nontemporal_store(o, (f32x4*)(p.out + (size_t)t * 1024 + k));
        }
      }
    }
  }
}

DI void phase_inproj(const Params& p, int l, bf16_t* lds) {
  const bf16_t* hbuf = (const bf16_t*)(p.ws + OFF_H);
  const bf16_t* wt = (const bf16_t*)(p.ws + OFF_WIN) + (size_t)l * 3072 * 1024;
  bf16_t* z = (bf16_t*)(p.ws + OFF_Z);
  bf16_t* vtb = (bf16_t*)(p.ws + OFF_VTB);
  bf16_t* vtd = (bf16_t*)(p.ws + OFF_VTD);
  float* rss = (float*)(p.ws + OFF_RSS);
  const float2* tm = (const float2*)(p.ws + OFF_TABM); const float2* tp = (const float2*)(p.ws + OFF_TABP); const float2* tx = (const float2*)(p.ws + OFF_TABX);
  const float SCB = 0.17677669529663687f * LOG2E;
  const float SCD = 0.125f * LOG2E;
  constexpr int NT = 12, MT = T_TOK / 256;
  {
    gemm_stream(hbuf, 1024, [&](int kt) { return kt * 64; }, wt, 1024, 16,
              [&](int q, int& tm0, int& tn0) { int mt, nt; const bool v = xcd_tile(q, NT, MT, mt, nt); nt = (nt + (mt >> 3)) % NT; tm0 = mt * 256; tn0 = nt * 256; return v; },
              [&](int m0, int n64, const f32x16& acc0, const f32x16& acc1) {
                const int lane = opaque_tid() & 63, r = lane & 31, h = lane >> 5;
                int seq, s0; tok2seq(m0, seq, s0);
                const int S = seq_len(seq), st = seq_start(seq);
                if (n64 >= ZC_QD && n64 < ZC_VD) {
                  const bool isq = n64 < ZC_KD;
                  const float* gn = (isq ? p.gqa_q_norm : p.gqa_k_norm) + l * 64;
                  const float g0 = gn[r], g1 = gn[32 + r];
                  const float scl = isq ? SCD : 1.f;
#pragma unroll
                  for (int i = 0; i < 16; ++i) {
                    float ss = acc0[i] * acc0[i] + acc1[i] * acc1[i];
                    ss += __shfl_xor(ss, 1); ss += __shfl_xor(ss, 2); ss += __shfl_xor(ss, 4); ss += __shfl_xor(ss, 8); ss += __shfl_xor(ss, 16);
                    const float rstd = rsqrtf(ss * (1.f / 64.f) + EPSN);
                    const int sp = s0 + crow(i, h);
                    const float x0 = acc0[i] * rstd * g0, x1 = acc1[i] * rstd * g1;
                    const float p0 = __shfl_xor(x0, 16), p1 = __shfl_xor(x1, 16);
                    const float2 c0 = tx[(sp >> 6) * 16 + (r & 15)], c1 = tx[(sp & 63) * 16 + (r & 15)];
                    const float o0 = (r < 16 ? x0 * c0.x - p0 * c0.y : x0 * c0.x + p0 * c0.y) * scl;
                    const float o1 = (r < 16 ? x1 * c1.x - p1 * c1.y : x1 * c1.x + p1 * c1.y) * scl;
                    bf16_t* zr = z + (size_t)(m0 + crow(i, h)) * ZS + n64 + r;
                    zr[0] = f2bf(o0); zr[32] = f2bf(o1);
                  }
                  return;
                }
                if (n64 >= ZC_QA && n64 < ZC_KRA) {
                  float* rs = rss + (size_t)(m0 + 4 * h) * 8 + ((n64 - ZC_QA) >> 6);
#pragma unroll
                  for (int i = 0; i < 16; ++i) {
                    float ss = acc0[i] * acc0[i] + acc1[i] * acc1[i];
                    ss += __shfl_xor(ss, 1); ss += __shfl_xor(ss, 2); ss += __shfl_xor(ss, 4); ss += __shfl_xor(ss, 8); ss += __shfl_xor(ss, 16);
                    if (r == 0) rs[((i & 3) + 8 * (i >> 2)) * 8] = ss;
                  }
                }
#pragma unroll
                for (int ni = 0; ni < 2; ++ni) {
                  const f32x16& acc = ni == 0 ? acc0 : acc1;
                  const int n0 = n64 + ni * 32;
                  const int n = n0 + r;
                  if (n0 >= ZC_VB && n0 < ZC_GB) {
                    bf16_t* base = vtb + (size_t)st * 256 + (size_t)(n - ZC_VB) * S + s0;
#pragma unroll
                    for (int g4 = 0; g4 < 4; ++g4)
                      *(uint2*)(base + 8 * g4 + 4 * h) = make_uint2(pack2(acc[4 * g4], acc[4 * g4 + 1]), pack2(acc[4 * g4 + 2], acc[4 * g4 + 3]));
                  } else if (n0 >= ZC_VD && n0 < ZC_GD) {
                    bf16_t* base = vtd + (size_t)st * 128 + (size_t)(n - ZC_VD) * S + s0;
#pragma unroll
                    for (int g4 = 0; g4 < 4; ++g4)
                      *(uint2*)(base + 8 * g4 + 4 * h) = make_uint2(pack2(acc[4 * g4], acc[4 * g4 + 1]), pack2(acc[4 * g4 + 2], acc[4 * g4 + 3]));
                  } else if (n0 < ZC_VB) {
                    const float scl = n0 < ZC_KB ? SCB : 1.f;
#pragma unroll
                    for (int i = 0; i < 16; ++i) {
                      const float x = acc[i];
                      const float pr = __shfl_xor(x, 4);
                      const float2 cs = tp[(s0 + crow(i, h)) * 4 + (r & 3)];
                      const float o = r < 4 ? x * cs.x - pr * cs.y : (r < 8 ? x * cs.x + pr * cs.y : x);
                      z[(size_t)(m0 + crow(i, h)) * ZS + n] = f2bf(o * scl);
                    }
                  } else if (n0 == ZC_KRA) {
#pragma unroll
                    for (int i = 0; i < 16; ++i) {
                      const float x = acc[i];
                      const float pr = __shfl_xor(x, 16);
                      const float2 cs = tm[(s0 + crow(i, h)) * 16 + (r & 15)];
                      z[(size_t)(m0 + crow(i, h)) * ZS + n] = f2bf(r < 16 ? x * cs.x - pr * cs.y : x * cs.x + pr * cs.y);
                    }
                  } else if (n0 < NIN) {
#pragma unroll
                    for (int i = 0; i < 16; ++i) z[(size_t)(m0 + crow(i, h)) * ZS + n] = f2bf(acc[i]);
                  }
                }
              },
              lds);
  }
}

DI void phase_mla_up(const Params& p, int l, bf16_t* lds) {
  const bf16_t* z = (const bf16_t*)(p.ws + OFF_Z);
  bf16_t* QA = (bf16_t*)(p.ws + OFF_QA);
  bf16_t* KA = (bf16_t*)(p.ws + OFF_KA);
  bf16_t* VTA = (bf16_t*)(p.ws + OFF_VTA);
  const bf16_t* wuq = (const bf16_t*)(p.ws + OFF_WUQ) + (size_t)l * 512 * 192;
  const bf16_t* wukv = (const bf16_t*)(p.ws + OFF_WUKV) + (size_t)l * 512 * 128;
  const float2* tm = (const float2*)(p.ws + OFF_TABM);
  const float* rss = (const float*)(p.ws + OFF_RSS);
  const int lane = opaque_tid() & 63, r = lane & 31, h = lane >> 5;
  const float SCA = 0.10206207261596577f * LOG2E;
  constexpr int MT = T_TOK / 256;
  for (int q = blockIdx.x >> 3;; q += gridDim.x >> 3) {
    int mt, sub;
    if (!xcd_tile(q, 4, MT, mt, sub)) break;
    sub = (sub + (mt >> 6)) & 3;
    if (sub < 2) {
      gemm_tile([&](int kt, const bf16_t*& ab, int& as) { ab = z + ZC_QA + kt * 64; as = ZS; }, wuq, 192, 3, mt * 256, sub * 256,
                [&](int m0, int n0, const f32x16& acc) {
                  if (n0 >= 384) return;
                  const int n = n0 + r;
                  const bool pe = ((n0 >> 5) % 3) == 2;
                  int seq, s0; tok2seq(m0, seq, s0);
#pragma unroll
                  for (int i = 0; i < 16; ++i) {
                    const float* rs = rss + (size_t)(m0 + crow(i, h)) * 8;
                    float x = acc[i] * rsqrtf((rs[0] + rs[1] + rs[2]) * (1.f / 192.f) + EPSN);
                    if (pe) {
                      float pr = __shfl_xor(x, 16);
                      float2 cs = tm[(s0 + crow(i, h)) * 16 + (r & 15)];
                      x = (r < 16) ? x * cs.x - pr * cs.y : x * cs.x + pr * cs.y;
                    }
                    QA[(size_t)(m0 + crow(i, h)) * 384 + n] = f2bf(x * SCA);
                  }
                },
                lds);
    } else {
      gemm_tile([&](int kt, const bf16_t*& ab, int& as) { ab = z + ZC_KVA + kt * 64; as = ZS; }, wukv, 128, 2, mt * 256, (sub - 2) * 256,
                [&](int m0, int n0, const f32x16& acc) {
                  const int hh = n0 >> 7;
                  const int nn = (n0 & 127) + r;
                  auto rstd_of = [&](int i) { const float* rs = rss + (size_t)(m0 + crow(i, h)) * 8; return rsqrtf((rs[3] + rs[4]) * (1.f / 128.f) + EPSN); };
                  if (nn < 64) {
#pragma unroll
                    for (int i = 0; i < 16; ++i) KA[(size_t)(m0 + crow(i, h)) * 384 + hh * 96 + nn] = f2bf(acc[i] * rstd_of(i));
                    if (nn >= 32) {
                      bf16_t kpe[16];
#pragma unroll
                      for (int i = 0; i < 16; ++i) kpe[i] = z[(size_t)(m0 + crow(i, h)) * ZS + ZC_KRA + r];
#pragma unroll
                      for (int i = 0; i < 16; ++i) KA[(size_t)(m0 + crow(i, h)) * 384 + hh * 96 + 64 + r] = kpe[i];
                    }
                  } else {
                    int seq, s; tok2seq(m0, seq, s); const int S = seq_len(seq), st = seq_start(seq);
                    bf16_t* base = VTA + (size_t)st * 256 + (size_t)(hh * 64 + nn - 64) * S + s;
#pragma unroll
                    for (int g4 = 0; g4 < 4; ++g4)
                      *(uint2*)(base + 8 * g4 + 4 * h) = make_uint2(pack2(acc[4 * g4] * rstd_of(4 * g4), acc[4 * g4 + 1] * rstd_of(4 * g4 + 1)), pack2(acc[4 * g4 + 2] * rstd_of(4 * g4 + 2), acc[4 * g4 + 3] * rstd_of(4 * g4 + 3)));
                  }
                },
                lds);
    }
  }
}

template <int DK, int KW, bool DIFF>
DI void attn_item(const bf16_t* qp, int qstride, const bf16_t* kp, int kstride, const bf16_t* vt, bf16_t* op, int ostride, const bf16_t* gp,
                  int S, int start, int qt, bf16_t* lds, float lam, float post_scale, const float* subln) {
  constexpr int KWP = KW + 8;
  constexpr int KCH = KW / 8;
  constexpr int KLD = (64 * KCH + 511) / 512;
  constexpr int NKS = DK / 16;
  bf16_t* Ks = lds;
  bf16_t* Vs = lds + 2 * 64 * KWP;
  float* Xc = (float*)(lds + 2 * 64 * KWP + 2 * 64 * 72);
  const int tid = opaque_tid(), lane = tid & 63, w = tid >> 6, r = lane & 31, h = lane >> 5;
  const int sub = DIFF ? (w >> 2) : 0;
  const int rblk = DIFF ? (w & 3) : w;
  const int koff = DIFF ? sub * DK : 0;
  const int qrow = start + qt * (DIFF ? 128 : 256) + rblk * 32 + r;
  bf16x8 qf[NKS];
#pragma unroll
  for (int ks = 0; ks < NKS; ++ks) qf[ks] = *(const bf16x8*)(qp + (size_t)qrow * qstride + koff + ks * 16 + 8 * h);
  constexpr bool USE_NM = true;
  f32x16 O[2], NM;
  float lrun = 0.f, mref = 0.f;
#pragma unroll
  for (int e = 0; e < 16; ++e) { O[0][e] = 0.f; O[1][e] = 0.f; NM[e] = 0.f; }
  u32x4 kreg[KLD], vreg;
  const int vrow = tid >> 3, vch = tid & 7;
  const int nt = S / 64;
  auto gloadK = [&](int t) {
#pragma unroll
    for (int i = 0; i < KLD; ++i) { int q = tid + 512 * i; int row = q / KCH, c = q % KCH; if (q < 64 * KCH) kreg[i] = *(const u32x4*)(kp + (size_t)(start + t * 64 + row) * kstride + c * 8); }
  };
  auto gloadV = [&](int t) { vreg = *(const u32x4*)(vt + (size_t)vrow * S + t * 64 + vch * 8); };
  auto storeK = [&](int buf) {
    bf16_t* kbn = Ks + buf * 64 * KWP;
#pragma unroll
    for (int i = 0; i < KLD; ++i) { int q = tid + 512 * i; int row = q / KCH, c = q % KCH; if (q < 64 * KCH) *(u32x4*)(kbn + row * KWP + c * 8) = kreg[i]; }
  };
  auto storeV = [&](int buf) {
    bf16_t* vbn = Vs + buf * 64 * 72;
    u32x2 lo2 = {vreg.x, vreg.y}; u32x2 hi2 = {vreg.z, vreg.w};
    bf16_t* dst = vbn + vrow * 72 + (vch >> 1) * 16 + (vch & 1) * 4;
    *(u32x2*)dst = lo2; *(u32x2*)(dst + 8) = hi2;
  };
  __syncthreads();
  gloadK(0); gloadV(0); storeK(0); storeV(0);
  gloadK(1); storeK(1);
  __syncthreads();
  f32x16 sc[2];
#pragma unroll
  for (int kb2 = 0; kb2 < 2; ++kb2) {
    sc[kb2] = NM;
#pragma unroll
    for (int ks = 0; ks < NKS; ++ks) {
      bf16x8 a = *(const bf16x8*)(Ks + (kb2 * 32 + r) * KWP + koff + ks * 16 + 8 * h);
      sc[kb2] = MFMA(a, qf[ks], sc[kb2]);
    }
  }
  if (w >= 4) __builtin_amdgcn_s_setprio(1);
  for (int t = 0; t < nt; ++t) {
    if (t + 2 < nt) gloadK(t + 2);
    if (t + 1 < nt) gloadV(t + 1);
    const bf16_t* kbn = Ks + ((t + 1) & 1) * 64 * KWP; const bf16_t* vb = Vs + (t & 1) * 64 * 72;
    u32x4 vf[2][4];
#pragma unroll
    for (int dvb = 0; dvb < 2; ++dvb)
#pragma unroll
      for (int c4 = 0; c4 < 2; ++c4) {
        vf[dvb][c4] = *(const u32x4*)(vb + (dvb * 32 + r) * 72 + c4 * 16 + 8 * h);
      }
    __builtin_amdgcn_sched_barrier(0);
    unsigned u0 = __float_as_uint(sc[0][0]), u1 = __float_as_uint(sc[0][1]), u2 = __float_as_uint(sc[1][0]), u3 = __float_as_uint(sc[1][1]);
#pragma unroll
    for (int e = 2; e < 16; e += 2) {
      u0 = min(u0, min(__float_as_uint(sc[0][e]), __float_as_uint(sc[0][e + 1])));
      u1 = min(u1, min(__float_as_uint(sc[1][e]), __float_as_uint(sc[1][e + 1])));
    }
    u0 = min(min(u0, u1), min(u2, u3));
    {
      auto rr = __builtin_amdgcn_permlane32_swap(u0, u0, false, false);
      u0 = min((unsigned)rr[0], (unsigned)rr[1]);
    }
    const float REF_GAP = 8.f;
    const float rel = USE_NM ? 0.f : mref;
    const bool grow = (u0 < 0x80000000u) || (__uint_as_float(u0) - rel > -2.f);
    if (t == 0 || __any(grow)) {
      float m0 = fmaxf(sc[0][0], sc[0][1]), m1 = fmaxf(sc[0][2], sc[0][3]), m2 = fmaxf(sc[1][0], sc[1][1]), m3 = fmaxf(sc[1][2], sc[1][3]);
#pragma unroll
      for (int e = 4; e < 16; e += 4) {
        m0 = fmaxf(m0, fmaxf(sc[0][e], sc[0][e + 1])); m1 = fmaxf(m1, fmaxf(sc[0][e + 2], sc[0][e + 3]));
        m2 = fmaxf(m2, fmaxf(sc[1][e], sc[1][e + 1])); m3 = fmaxf(m3, fmaxf(sc[1][e + 2], sc[1][e + 3]));
      }
      const float mx = xhalf_max(fmaxf(fmaxf(m0, m1), fmaxf(m2, m3))) - rel;
      const float delta = (t == 0) ? mx + REF_GAP : fmaxf(mx + REF_GAP, 0.f);
      const float corr = __builtin_amdgcn_exp2f(-delta);
      lrun *= corr;
      mref += delta;
#pragma unroll
      for (int e = 0; e < 16; ++e) {
        if (USE_NM) { sc[0][e] -= delta; sc[1][e] -= delta; NM[e] -= delta; }
        O[0][e] *= corr; O[1][e] *= corr;
      }
    }
    float p0 = 0.f, p1 = 0.f, p2 = 0.f, p3 = 0.f;
    bf16x8 pf[4];
#pragma unroll
    for (int kb2 = 0; kb2 < 2; ++kb2)
#pragma unroll
      for (int s2 = 0; s2 < 2; ++s2) {
        float a[8];
#pragma unroll
        for (int e = 0; e < 8; ++e) a[e] = __builtin_amdgcn_exp2f(USE_NM ? sc[kb2][8 * s2 + e] : sc[kb2][8 * s2 + e] - mref);
        p0 += a[0] + a[4]; p1 += a[1] + a[5]; p2 += a[2] + a[6]; p3 += a[3] + a[7];
        u32x4 pu = {pack2(a[0], a[1]), pack2(a[2], a[3]), pack2(a[4], a[5]), pack2(a[6], a[7])};
        pf[kb2 * 2 + s2] = __builtin_bit_cast(bf16x8, pu);
      }
    lrun += (p0 + p1) + (p2 + p3);
    bf16x8 kf0[NKS], kf1[NKS];
#pragma unroll
    for (int ks = 0; ks < NKS; ++ks) kf0[ks] = *(const bf16x8*)(kbn + r * KWP + koff + ks * 16 + 8 * h);
    __builtin_amdgcn_sched_barrier(0);
#pragma unroll
    for (int c4 = 0; c4 < 2; ++c4)
#pragma unroll
      for (int dvb = 0; dvb < 2; ++dvb) O[dvb] = MFMA(__builtin_bit_cast(bf16x8, vf[dvb][c4]), pf[c4], O[dvb]);
#pragma unroll
    for (int dvb = 0; dvb < 2; ++dvb)
#pragma unroll
      for (int c4 = 2; c4 < 4; ++c4) {
        vf[dvb][c4] = *(const u32x4*)(vb + (dvb * 32 + r) * 72 + c4 * 16 + 8 * h);
      }
#pragma unroll
    for (int ks = 0; ks < NKS; ++ks) kf1[ks] = *(const bf16x8*)(kbn + (32 + r) * KWP + koff + ks * 16 + 8 * h);
    __builtin_amdgcn_sched_barrier(0);
    sc[0] = NM; sc[1] = NM;
#pragma unroll
    for (int ks = 0; ks < NKS; ++ks) sc[0] = MFMA(kf0[ks], qf[ks], sc[0]);
#pragma unroll
    for (int c4 = 2; c4 < 4; ++c4)
#pragma unroll
      for (int dvb = 0; dvb < 2; ++dvb) O[dvb] = MFMA(__builtin_bit_cast(bf16x8, vf[dvb][c4]), pf[c4], O[dvb]);
#pragma unroll
    for (int ks = 0; ks < NKS; ++ks) sc[1] = MFMA(kf1[ks], qf[ks], sc[1]);
    if (t + 2 < nt) storeK(t & 1);
    if (t + 1 < nt) storeV((t + 1) & 1);
    __syncthreads();
  }
  __builtin_amdgcn_s_setprio(0);
  u32x2 gall[2][4];
#pragma unroll
  for (int dvb = 0; dvb < 2; ++dvb)
#pragma unroll
    for (int g4 = 0; g4 < 4; ++g4) gall[dvb][g4] = *(const u32x2*)(gp + (size_t)qrow * ZS + dvb * 32 + 8 * g4 + 4 * h);
  const float lt = xhalf_sum(lrun);
  const float inv = 1.f / lt;
  if (DIFF) {
    if (sub == 1) {
#pragma unroll
      for (int dvb = 0; dvb < 2; ++dvb)
#pragma unroll
        for (int e = 0; e < 16; ++e) Xc[(rblk * 64 + dvb * 32 + crow(e, h)) * 32 + r] = O[dvb][e] * inv;
    }
    __syncthreads();
    if (sub == 0) {
      float ss = 0.f;
#pragma unroll
      for (int dvb = 0; dvb < 2; ++dvb)
#pragma unroll
        for (int e = 0; e < 16; ++e) { float v = O[dvb][e] * inv - lam * Xc[(rblk * 64 + dvb * 32 + crow(e, h)) * 32 + r]; O[dvb][e] = v; ss += v * v; }
      ss = xhalf_sum(ss);
      const float rstd = rsqrtf(ss * (1.f / 64.f) + EPSN) * post_scale;
#pragma unroll
      for (int dvb = 0; dvb < 2; ++dvb)
#pragma unroll
        for (int g4 = 0; g4 < 4; ++g4) {
          const int dv = dvb * 32 + 8 * g4 + 4 * h;
          const u32x2 gu = gall[dvb][g4];
          float g0 = silu_f(bflo(gu.x)), g1 = silu_f(bfhi(gu.x)), g2 = silu_f(bflo(gu.y)), g3 = silu_f(bfhi(gu.y));
          float o0 = O[dvb][4 * g4] * rstd * subln[dv] * g0, o1 = O[dvb][4 * g4 + 1] * rstd * subln[dv + 1] * g1;
          float o2 = O[dvb][4 * g4 + 2] * rstd * subln[dv + 2] * g2, o3 = O[dvb][4 * g4 + 3] * rstd * subln[dv + 3] * g3;
          u32x2 ou = {pack2(o0, o1), pack2(o2, o3)};
          *(u32x2*)(op + (size_t)qrow * ostride + dv) = ou;
        }
    }
  } else {
#pragma unroll
    for (int dvb = 0; dvb < 2; ++dvb)
#pragma unroll
      for (int g4 = 0; g4 < 4; ++g4) {
        const int dv = dvb * 32 + 8 * g4 + 4 * h;
        const u32x2 gu = gall[dvb][g4];
        float g0 = silu_f(bflo(gu.x)), g1 = silu_f(bfhi(gu.x)), g2 = silu_f(bflo(gu.y)), g3 = silu_f(bfhi(gu.y));
        float o0 = O[dvb][4 * g4] * inv * g0, o1 = O[dvb][4 * g4 + 1] * inv * g1;
        float o2 = O[dvb][4 * g4 + 2] * inv * g2, o3 = O[dvb][4 * g4 + 3] * inv * g3;
        u32x2 ou = {pack2(o0, o1), pack2(o2, o3)};
        *(u32x2*)(op + (size_t)qrow * ostride + dv) = ou;
      }
  }
}

DI void scan_item(const Params& p, int l, int seq, int hh, char* ldsraw0) {
  const int tid512 = opaque_tid();
  const int dir = tid512 >> 8;
  char* ldsraw = ldsraw0 + dir * 61440;
  bf16_t* Xs = (bf16_t*)ldsraw;
  float* Xf = (float*)(ldsraw + 9216);
  float* Aa = Xf + 4096;
  float* Bb = Aa + 4096;
  float* SegA = Bb + 4096;
  float* SegB = SegA + 256;
  float* carry = SegB + 256;
  const int tid = tid512 & 255, lane = tid & 63, w = tid >> 6, r = lane & 31, h = lane >> 5;
  const int mi = w >> 1, ni = w & 1;
  const int S = seq_len(seq), start = seq_start(seq);
  const bf16_t* z = (const bf16_t*)(p.ws + OFF_Z);
  bf16_t* zw = (bf16_t*)(p.ws + OFF_Z);
  bf16_t* hfb = (bf16_t*)(p.ws + OFF_HFB);
  const bf16_t* wl = (const bf16_t*)(p.ws + OFF_WLRU);
  bf16x8 wf[2][4];
#pragma unroll
  for (int mat = 0; mat < 2; ++mat)
#pragma unroll
    for (int ks = 0; ks < 4; ++ks)
      wf[mat][ks] = *(const bf16x8*)(wl + (size_t)((((l * 2 + dir) * 2 + mat) * 4 + hh) * 64 + ni * 32 + r) * 64 + ks * 16 + 8 * h);
  const int che = hh * 64 + ni * 32 + r;
  const float ba = p.lru_ba[(l * 2 + dir) * 256 + che], bx = p.lru_bx[(l * 2 + dir) * 256 + che];
  const float sp8 = 8.f * log1pf(expf(-p.lru_lambda[(l * 2 + dir) * 256 + che]));
  const int c = tid & 63, q = tid >> 6;
  const int chs = hh * 64 + c;
  const float cw0 = p.conv_w[(l * 4 + 0) * 256 + chs], cw1 = p.conv_w[(l * 4 + 1) * 256 + chs], cw2 = p.conv_w[(l * 4 + 2) * 256 + chs], cw3 = p.conv_w[(l * 4 + 3) * 256 + chs];
  const float cb = p.conv_b[l * 256 + chs];
  __syncthreads();
  if (tid < 128) carry[tid] = 0.f;
  const int ntile = S / 64;
  const bf16_t* zx = z + (size_t)start * ZS + ZC_XC + chs;
  const bf16_t* zg = z + (size_t)start * ZS + ZC_GC + chs;
  bf16_t xn[19];
  {
    const int sb = (dir ? S - 64 : 0) + q * 16 - 2;
#pragma unroll
    for (int e = 0; e < 19; ++e) { int sp = sb + e; xn[e] = (sp >= 0 && sp < S) ? zx[(size_t)sp * ZS] : (bf16_t)0; }
  }
  for (int tile = 0; tile < ntile; ++tile) {
    const int p0 = dir ? S - 64 * (tile + 1) : 64 * tile;
    float xv[19];
#pragma unroll
    for (int e = 0; e < 19; ++e) xv[e] = bf2f(xn[e]);
    if (tile + 1 < ntile) {
      const int sb = (dir ? S - 64 * (tile + 2) : 64 * (tile + 1)) + q * 16 - 2;
#pragma unroll
      for (int e = 0; e < 19; ++e) { int sp = sb + e; xn[e] = (sp >= 0 && sp < S) ? zx[(size_t)sp * ZS] : (bf16_t)0; }
    }
    const bool first = tile < (ntile >> 1);
    unsigned gp[16];
    if (!first) {
#pragma unroll
      for (int jj = 0; jj < 16; ++jj) {
        const int u = q * 16 + jj; const int tok = dir ? 63 - u : u;
        gp[jj] = (unsigned)zg[(size_t)(p0 + tok) * ZS] | ((unsigned)hfb[(size_t)(start + p0 + tok) * 512 + (1 - dir) * 256 + chs] << 16);
      }
    }
#pragma unroll
    for (int jj = 0; jj < 16; ++jj) {
      float xc = cb + cw0 * xv[jj] + cw1 * xv[jj + 1] + cw2 * xv[jj + 2] + cw3 * xv[jj + 3];
      Xs[(q * 16 + jj) * 72 + c] = f2bf(xc);
      Xf[(q * 16 + jj) * 64 + c] = xc;
    }
    __syncthreads();
    {
      f32x16 aR, aI;
#pragma unroll
      for (int e = 0; e < 16; ++e) { aR[e] = 0.f; aI[e] = 0.f; }
#pragma unroll
      for (int ks = 0; ks < 4; ++ks) {
        bf16x8 a = *(const bf16x8*)(Xs + (mi * 32 + r) * 72 + ks * 16 + 8 * h);
        aR = MFMA(a, wf[0][ks], aR);
        aI = MFMA(a, wf[1][ks], aI);
      }
#pragma unroll
      for (int i = 0; i < 16; ++i) {
        const int tok = mi * 32 + crow(i, h), ch = ni * 32 + r;
        const float rr = __builtin_amdgcn_rcpf(1.f + __expf(-(aR[i] + ba)));
        const float ii = __builtin_amdgcn_rcpf(1.f + __expf(-(aI[i] + bx)));
        const float xq = Xf[tok * 64 + ch];
        const float log_a = -sp8 * rr;
        const float a = __expf(log_a);
        const float x2 = 2.f * log_a;
        const float ser = -x2 * (1.f + x2 * (0.5f + x2 * (0.16666667f + x2 * 0.041666668f)));
        const float om = x2 > -0.1f ? ser : 1.f - __expf(x2);
        const float gx = __builtin_amdgcn_sqrtf(om) * (ii * xq);
        Aa[tok * 64 + ch] = a; Bb[tok * 64 + ch] = gx;
      }
    }
    __syncthreads();
    float Ac[16], Bc[16];
    {
      float A = 1.f, B = 0.f;
#pragma unroll
      for (int jj = 0; jj < 16; ++jj) {
        const int u = q * 16 + jj; const int tok = dir ? 63 - u : u;
        float a = Aa[tok * 64 + c], b = Bb[tok * 64 + c];
        B = a * B + b; A = A * a; Ac[jj] = A; Bc[jj] = B;
      }
      SegA[q * 64 + c] = A; SegB[q * 64 + c] = B;
    }
    __syncthreads();
    {
      float cin = carry[(tile & 1) * 64 + c];
      for (int qq = 0; qq < q; ++qq) cin = SegA[qq * 64 + c] * cin + SegB[qq * 64 + c];
#pragma unroll
      for (int jj = 0; jj < 16; ++jj) {
        const int u = q * 16 + jj; const int tok = dir ? 63 - u : u;
        float hv = Ac[jj] * cin + Bc[jj];
        const size_t trow = (size_t)(start + p0 + tok);
        if (first) hfb[trow * 512 + dir * 256 + chs] = f2bf(hv);
        else zw[trow * ZS + ZC_GC + chs] = f2bf((hv + bfhi(gp[jj])) * silu_f(bflo(gp[jj])));
        if (jj == 15 && q == 3) carry[((tile + 1) & 1) * 64 + c] = hv;
      }
    }
    __syncthreads();
  }
}

DI void phase_mix(const Params& p, int l, char* ldsraw) {
  __shared__ int s_item;
  const int tid = threadIdx.x;
  const int x = blockIdx.x & 7;
  int* ctr = (int*)(p.ws + OFF_CTR) + l * 8 + x;
  bf16_t* z = (bf16_t*)(p.ws + OFF_Z);
  bf16_t* QA = (bf16_t*)(p.ws + OFF_QA);
  bf16_t* KA = (bf16_t*)(p.ws + OFF_KA);
  const bf16_t* VTA = (const bf16_t*)(p.ws + OFF_VTA);
  const bf16_t* VTB = (const bf16_t*)(p.ws + OFF_VTB);
  const bf16_t* VTD = (const bf16_t*)(p.ws + OFF_VTD);
  const float lam = ((const float*)(p.ws + OFF_LAM))[l];
  const float lam_init = l == 0 ? 0.2f : 0.8f - 0.6f * 0.7408182206817179f;
  constexpr int N_ITEMS = 16 + 512 + 256;
  while (true) {
    __syncthreads();
    if (tid == 0) s_item = atomicAdd(ctr, 1);
    __syncthreads();
    int j = __builtin_amdgcn_readfirstlane(s_item);
    if (j >= N_ITEMS) break;
    if (j < 16) { const int id = j * 8 + x; scan_item(p, l, id >> 2, id & 3, ldsraw); continue; }
    j -= 16;
    int type, seq, head, qt;
    if (j < 512) {
      if (j < 256) { type = 1; const int gg = (j >> 5) * 8 + x; seq = gg >> 2; head = gg & 3; qt = j & 31; }
      else { type = j < 384 ? 2 : 0; const int jj = j & 127; const int gg = (jj >> 4) * 8 + x; seq = gg >> 2; head = gg & 3; qt = jj & 15; }
    } else {
      j -= 512;
      if (j < 128) { type = 1; const int gg = (j >> 4) * 8 + x; seq = 16 + (gg >> 2); head = gg & 3; qt = j & 15; }
      else { type = j < 192 ? 2 : 0; const int jj = j & 63; const int gg = (jj >> 3) * 8 + x; seq = 16 + (gg >> 2); head = gg & 3; qt = jj & 7; }
    }
    const int S = seq_len(seq), start = seq_start(seq);
    if (type == 0) {
      attn_item<96, 96, false>(QA + head * 96, 384, KA + head * 96, 384, VTA + (size_t)start * 256 + (size_t)head * 64 * S,
                               z + ZC_VB + head * 64, ZS, z + ZC_GA + head * 64, S, start, qt, (bf16_t*)ldsraw, 0.f, 0.f, nullptr);
    } else if (type == 1) {
      attn_item<32, 64, true>(z + ZC_QB + head * 64, ZS, z + ZC_KB + head * 64, ZS, VTB + (size_t)start * 256 + (size_t)head * 64 * S,
                              z + ZC_QB + head * 64, ZS, z + ZC_GB + head * 64, S, start, qt, (bf16_t*)ldsraw, lam, 1.f - lam_init, p.diff_subln + l * 64);
    } else {
      attn_item<64, 64, false>(z + ZC_QD + head * 64, ZS, z + ZC_KD + (head >> 1) * 64, ZS, VTD + (size_t)start * 128 + (size_t)(head >> 1) * 64 * S,
                               z + ZC_QD + head * 64, ZS, z + ZC_GD + head * 64, S, start, qt, (bf16_t*)ldsraw, 0.f, 0.f, nullptr);
    }
  }
}

DI void phase_outproj(const Params& p, int l, bf16_t* lds) {
  const bf16_t* z = (const bf16_t*)(p.ws + OFF_Z);
  const bf16_t* QA = (const bf16_t*)(p.ws + OFF_QA);
  const bf16_t* hfb = (const bf16_t*)(p.ws + OFF_HFB);
  const bf16_t* wt = (const bf16_t*)(p.ws + OFF_WOUT) + (size_t)l * 1024 * 1024;
  const float* modp = (const float*)(p.ws + OFF_MOD) + (size_t)l * 32 * 3072;
  const int lane = opaque_tid() & 63, r = lane & 31, h = lane >> 5;
  constexpr int NT = 4, MT = T_TOK / 256;
  {
    gemm_stream(z, ZS,
        [&](int kt) {
          const int grp = kt >> 2, sub = kt & 3;
          const int col = grp == 0 ? ZC_VB : (grp == 1 ? ZC_QB : (grp == 2 ? ZC_GC : ZC_QD));
          return col + sub * 64;
        },
        wt, 1024, 16,
        [&](int q, int& tm0, int& tn0) { int mt, nt; const bool v = xcd_tile(q, NT, MT, mt, nt); tm0 = mt * 256; tn0 = nt * 256; return v; },
        [&](int m0, int n64, const f32x16& acc0, const f32x16& acc1) {
         const int lane = opaque_tid() & 63, r = lane & 31, h = lane >> 5;
         const int n = n64 + r;
         int seq, s; tok2seq(m0, seq, s);
         const float gate0 = modp[seq * 3072 + 2048 + n], gate1 = modp[seq * 3072 + 2048 + n + 32];
         const float* xb = (l == 0) ? (m0 < T_P ? p.xin0 + (size_t)m0 * 1024 : p.xin1 + (size_t)(m0 - T_P) * 1024) : p.out + (size_t)m0 * 1024;
         xb += (size_t)(4 * h) * 1024 + n;
         float* ob = p.out + (size_t)(m0 + 4 * h) * 1024 + n;
         float x0[16], x1[16];
#pragma unroll
         for (int i = 0; i < 16; ++i) { const int ro = ((i & 3) + 8 * (i >> 2)) * 1024; x0[i] = __builtin_nontemporal_load(xb + ro); x1[i] = __builtin_nontemporal_load(xb + ro + 32); }
#pragma unroll
         for (int i = 0; i < 16; ++i) { const int ro = ((i & 3) + 8 * (i >> 2)) * 1024; ob[ro] = x0[i] + gate0 * acc0[i]; ob[ro + 32] = x1[i] + gate1 * acc1[i]; }
        },
        lds);
  }
}

__global__ void __launch_bounds__(512, 2) hymba_fwd(Params p) {
  cg::grid_group grid = cg::this_grid();
  unsigned* gbar = (unsigned*)(p.ws + OFF_CTR) + 48;
  const unsigned nblk = gridDim.x;
  unsigned gb_n = 0;
  __shared__ __attribute__((aligned(16))) char lds[147456];
  phase0a(p, (float*)lds);
  grid.sync();
  phase_norm(p, 0, 0, true);
  grid_barrier(gbar, nblk * (++gb_n));
#pragma unroll 1
  for (int l = 0; l < 2; ++l) {
    phase_inproj(p, l, (bf16_t*)lds);
    grid_barrier(gbar, nblk * (++gb_n));
    phase_mla_up(p, l, (bf16_t*)lds);
    grid_barrier(gbar, nblk * (++gb_n));
    phase_mix(p, l, lds);
    grid_barrier(gbar, nblk * (++gb_n));
    phase_outproj(p, l, (bf16_t*)lds);
    grid_barrier(gbar, nblk * (++gb_n));
    if (l == 0) { phase_norm(p, 1, 0, false); grid_barrier(gbar, nblk * (++gb_n)); }
    else phase_norm(p, 0, 1, false);
  }
}

extern "C" void kernel_launch(void* const* d_in, const int* in_sizes, int n_in, void* d_out, int out_size, void* d_ws, size_t ws_size, hipStream_t stream) {
  if (ws_size < WS_NEED) { fprintf(stderr, "workspace too small: %zu < %zu\n", ws_size, (size_t)WS_NEED); return; }
  static int grid_blocks = 0;
  if (!grid_blocks) {
    int dev = 0, cus = 0, per_cu = 0;
    hipGetDevice(&dev);
    hipDeviceGetAttribute(&cus, hipDeviceAttributeMultiprocessorCount, dev);
    hipOccupancyMaxActiveBlocksPerMultiprocessor(&per_cu, hymba_fwd, 512, 0);
    if (per_cu > 1) per_cu = 1;
    if (per_cu < 1) per_cu = 1;
    grid_blocks = (cus * per_cu) & ~7;
  }
  Params p{};
  p.xin0 = (const float*)d_in[0]; p.xin1 = (const float*)d_in[1]; p.c0 = (const float*)d_in[2]; p.c1 = (const float*)d_in[3];
  p.ada_w = (const float*)d_in[4]; p.ada_b = (const float*)d_in[5]; p.norm_g = (const float*)d_in[6]; p.w_in = (const float*)d_in[7];
  p.mla_q_norm = (const float*)d_in[8]; p.mla_w_uq = (const float*)d_in[9]; p.mla_kv_norm = (const float*)d_in[10]; p.mla_w_ukv = (const float*)d_in[11];
  p.diff_lambda = (const float*)d_in[12]; p.diff_subln = (const float*)d_in[13]; p.conv_w = (const float*)d_in[14]; p.conv_b = (const float*)d_in[15];
  p.lru_wa = (const float*)d_in[16]; p.lru_ba = (const float*)d_in[17]; p.lru_wx = (const float*)d_in[18]; p.lru_bx = (const float*)d_in[19];
  p.lru_lambda = (const float*)d_in[20]; p.gqa_q_norm = (const float*)d_in[21]; p.gqa_k_norm = (const float*)d_in[22]; p.w_out = (const float*)d_in[23];
  p.final_norm = (const float*)d_in[24];
  p.out = (float*)d_out; p.ws = (char*)d_ws;
  hipMemsetAsync((char*)d_ws + OFF_CTR, 0, 256, stream);
  void* args[] = {&p};
  hipError_t e = hipLaunchCooperativeKernel((void*)hymba_fwd, dim3(grid_blocks), dim3(512), args, 0, stream);
  if (e != hipSuccess) fprintf(stderr, "cooperative launch failed: %s (grid %d)\n", hipGetErrorString(e), grid_blocks);
}
```
